# Optimizing an MI355X kernel written in HIP

```python
import jax, jax.numpy as jnp
from jax import lax
import numpy as np

D_MODEL = 1024
BATCH = 8
SEQ = 2048
DEPTH = 1
DEC_BATCH = 128
DEC_SEQ = 8
PAST_LEN = 16384
PAGE_SIZE = 128

D_MIX = D_MODEL
D_A = D_MIX // 2
D_B = D_MIX - D_A
H_A = 4
DK_A = D_A // H_A
DV_A = D_A // H_A
H_B = 4
DH_B = D_B // H_B
CMLP_CHUNK = 128
GLA_CHUNK = 64
D_FF = -(-8 * D_MODEL // (3 * 256)) * 256
N_IN = 4 * D_A + 2 * D_B
EPS = 1e-6

kernel_name = "hymba_hgrn2_chunkmlp_decoder_step"


def rmsnorm(x, g):
    xf = x.astype(jnp.float32)
    y = xf * lax.rsqrt(jnp.mean(xf * xf, axis=-1, keepdims=True) + EPS)
    return (y * g.astype(jnp.float32)).astype(x.dtype)


def layernorm(x, g, b):
    xf = x.astype(jnp.float32)
    mu = jnp.mean(xf, axis=-1, keepdims=True)
    xc = xf - mu
    y = xc * lax.rsqrt(jnp.mean(xc * xc, axis=-1, keepdims=True) + EPS)
    return (y * g.astype(jnp.float32) + b.astype(jnp.float32)).astype(x.dtype)


def hgrn2_recurrence(q, logf, k, v, s0):
    B, L = q.shape[0], q.shape[1]
    C = GLA_CHUNK
    N = -(-L // C)
    pad = N * C - L
    padw = ((0, 0), (0, pad), (0, 0), (0, 0))
    q, logf, k, v = [jnp.pad(a.astype(jnp.float32), padw).reshape((B, N, C) + a.shape[2:])
                     for a in (q, logf, k, v)]
    b = jnp.cumsum(logf, axis=2)
    b_last = b[:, :, -1:]
    qd = q * jnp.exp(b)
    kd = k * jnp.exp(-b)
    causal = jnp.tril(jnp.ones((C, C), dtype=bool))
    scores = jnp.einsum('bnthk,bnshk->bnhts', qd, kd)
    scores = jnp.where(causal, scores, 0.0)
    o_intra = jnp.einsum('bnhts,bnshv->bnthv', scores, v)
    k_end = k * jnp.exp(b_last - b)
    ds = jnp.einsum('bnshk,bnshv->bnhkv', k_end, v)
    decay = jnp.exp(b_last[:, :, 0])

    def step(s, inp):
        d, dsn = inp
        return d[..., None] * s + dsn, s

    s_final, s_start = lax.scan(step, s0, (jnp.moveaxis(decay, 1, 0), jnp.moveaxis(ds, 1, 0)))
    s_start = jnp.moveaxis(s_start, 0, 1)
    o_inter = jnp.einsum('bnthk,bnhkv->bnthv', qd, s_start)
    o = (o_intra + o_inter).reshape(B, N * C, q.shape[3], v.shape[4])[:, :L]
    return o, s_final


def hgrn2_mixer(zq, zf, zi, zg, lb, gnorm_w, s0):
    B, L, _ = zq.shape
    q = zq.reshape(B, L, H_A, DK_A)
    lbh = lb.reshape(H_A, DK_A)
    f = lbh + (1.0 - lbh) * jax.nn.sigmoid(zf.reshape(B, L, H_A, DK_A).astype(jnp.float32))
    logf = jnp.log(f)
    k = 1.0 - f
    v = zi.reshape(B, L, H_A, DV_A)
    o, s_new = hgrn2_recurrence(q, logf, k, v, s0.astype(jnp.float32))
    o = rmsnorm(o, gnorm_w) * jax.nn.silu(zg.reshape(B, L, H_A, DV_A).astype(jnp.float32))
    return o.reshape(B, L, D_A).astype(zq.dtype), s_new


def chunk_mlp_mixer(zu, zv, ln_g, ln_b, w_s, b_s):
    B, L, _ = zu.shape
    C = CMLP_CHUNK
    u = jax.nn.gelu(zu).reshape(B, L, H_B, DH_B)
    v = layernorm(jax.nn.gelu(zv), ln_g, ln_b).reshape(B, L, H_B, DH_B)
    N = -(-L // C)
    pad = N * C - L
    vp = jnp.pad(v, ((0, 0), (0, pad), (0, 0), (0, 0))).reshape(B, N, C, H_B, DH_B)
    ws = jnp.where(jnp.tril(jnp.ones((C, C), dtype=bool)), w_s, 0.0)
    mixed = jnp.einsum('hts,bnshd->bnthd', ws, vp) + jnp.transpose(b_s)[None, None, :, :, None]
    mixed = mixed.reshape(B, N * C, H_B, DH_B)[:, :L]
    out = (u * mixed).reshape(B, L, D_B)
    v_rows = v[:, ((L - 1) // C) * C:]
    return out, v_rows


def decoder_layer(x, c, s0, lb, w_ada, b_ada, norm_pre_mix, norm_post_mix, w_in, gnorm_w,
                  ln_v_g, ln_v_b, w_spatial, b_spatial, w_out, norm_pre_ffn, norm_post_ffn,
                  w_gate, w_up, w_down):
    mod = (jax.nn.silu(c) @ w_ada + b_ada)[:, None, :]
    sh1, sc1, g1, sh2, sc2, g2 = jnp.split(mod, 6, axis=-1)
    h = rmsnorm(x, norm_pre_mix) * (1.0 + sc1) + sh1
    z = h @ w_in
    zq, zf, zi, zg, zu, zv = jnp.split(
        z, [D_A, 2 * D_A, 3 * D_A, 4 * D_A, 4 * D_A + D_B], axis=-1)
    oa, s_new = hgrn2_mixer(zq, zf, zi, zg, lb, gnorm_w, s0)
    ob, v_rows = chunk_mlp_mixer(zu, zv, ln_v_g, ln_v_b, w_spatial, b_spatial)
    m = jnp.concatenate([oa, ob], axis=-1) @ w_out
    x = x + g1 * rmsnorm(m, norm_post_mix)
    h2 = rmsnorm(x, norm_pre_ffn) * (1.0 + sc2) + sh2
    f = (jax.nn.silu(h2 @ w_gate) * (h2 @ w_up)) @ w_down
    x = x + g2 * rmsnorm(f, norm_post_ffn)
    return x, s_new, v_rows


def setup_inputs(seed: int = 0) -> dict:
    key = jax.random.key(seed)
    ks = jax.random.split(key, 24)

    def nrm(k, shape, s):
        return s * jax.random.normal(k, shape, jnp.float32)

    return {
        "x_prompt": nrm(ks[0], (BATCH, SEQ, D_MODEL), 1.0),
        "x_sample": nrm(ks[1], (DEC_BATCH, DEC_SEQ, D_MODEL), 1.0),
        "state_hgrn": nrm(ks[2], (DEPTH, DEC_BATCH, H_A, DK_A, DV_A), 0.5),
        "c_prompt": nrm(ks[3], (BATCH, D_MODEL), 1.0),
        "c_sample": nrm(ks[4], (DEC_BATCH, D_MODEL), 1.0),
        "lb_logits": nrm(ks[5], (DEPTH + 1, D_A), 0.1),
        "w_ada": nrm(ks[6], (DEPTH, D_MODEL, 6 * D_MODEL), 0.3 * D_MODEL ** -0.5),
        "b_ada": nrm(ks[7], (DEPTH, 6 * D_MODEL), 0.1),
        "norm_pre_mix": 1.0 + nrm(ks[8], (DEPTH, D_MODEL), 0.1),
        "norm_post_mix": 1.0 + nrm(ks[9], (DEPTH, D_MODEL), 0.1),
        "w_in": nrm(ks[10], (DEPTH, D_MODEL, N_IN), D_MODEL ** -0.5),
        "gnorm_w": 1.0 + nrm(ks[11], (DEPTH, DV_A), 0.1),
        "ln_v_g": 1.0 + nrm(ks[12], (DEPTH, D_B), 0.1),
        "ln_v_b": nrm(ks[13], (DEPTH, D_B), 0.1),
        "w_spatial": nrm(ks[14], (DEPTH, H_B, CMLP_CHUNK, CMLP_CHUNK), CMLP_CHUNK ** -0.5),
        "b_spatial": 1.0 + nrm(ks[15], (DEPTH, H_B, CMLP_CHUNK), 0.1),
        "w_out": nrm(ks[16], (DEPTH, D_MIX, D_MODEL), D_MIX ** -0.5),
        "norm_pre_ffn": 1.0 + nrm(ks[17], (DEPTH, D_MODEL), 0.1),
        "norm_post_ffn": 1.0 + nrm(ks[18], (DEPTH, D_MODEL), 0.1),
        "w_gate": nrm(ks[19], (DEPTH, D_MODEL, D_FF), D_MODEL ** -0.5),
        "w_up": nrm(ks[20], (DEPTH, D_MODEL, D_FF), D_MODEL ** -0.5),
        "w_down": nrm(ks[21], (DEPTH, D_FF, D_MODEL), D_FF ** -0.5),
    }


def reference(x_prompt, x_sample, state_hgrn, c_prompt, c_sample, lb_logits, w_ada, b_ada,
              norm_pre_mix, norm_post_mix, w_in, gnorm_w, ln_v_g, ln_v_b, w_spatial, b_spatial,
              w_out, norm_pre_ffn, norm_post_ffn, w_gate, w_up, w_down):
    lb_all = jnp.cumsum(jax.nn.softmax(lb_logits.astype(jnp.float32), axis=0), axis=0)
    xp, xs = x_prompt, x_sample
    s_p_list, s_s_list, v_p_list, v_s_list = [], [], [], []
    for l in range(DEPTH):
        params = (w_ada[l], b_ada[l], norm_pre_mix[l], norm_post_mix[l], w_in[l], gnorm_w[l],
                  ln_v_g[l], ln_v_b[l], w_spatial[l], b_spatial[l], w_out[l], norm_pre_ffn[l],
                  norm_post_ffn[l], w_gate[l], w_up[l], w_down[l])
        s0_prompt = jnp.zeros((xp.shape[0], H_A, DK_A, DV_A), jnp.float32)
        xp, sp, vp = decoder_layer(xp, c_prompt, s0_prompt, lb_all[l], *params)
        xs, ss, vs = decoder_layer(xs, c_sample, state_hgrn[l], lb_all[l], *params)
        s_p_list.append(sp.astype(x_prompt.dtype))
        s_s_list.append(ss.astype(state_hgrn.dtype))
        v_p_list.append(vp)
        v_s_list.append(vs)
    state_hgrn_prompt = jnp.stack(s_p_list)
    state_hgrn_sample = jnp.stack(s_s_list)
    state_cmlp_v_prompt = jnp.stack(v_p_list)
    state_cmlp_v_sample = jnp.stack(v_s_list)
    return (xp, xs, state_hgrn_prompt, state_hgrn_sample, state_cmlp_v_prompt, state_cmlp_v_sample)
```

```cpp
#define MK_N_LAUNCHES 12
#include <hip/hip_runtime.h>
#include <hip/hip_cooperative_groups.h>
#include <cstdio>
#include <cstdint>
namespace pg8 {
#define PG8_LAS __attribute__((address_space(3)))
typedef unsigned short bf16_t;
typedef short bf16x8 __attribute__((ext_vector_type(8)));
typedef float f32x4 __attribute__((ext_vector_type(4)));
typedef unsigned u32x4 __attribute__((ext_vector_type(4)));
constexpr int BM = 256, BK = 64, HALF = 128, HTB = HALF * BK * 2  , STAGE_BYTES = 8 * HTB, NXCD = 8, WGM = 8;

__host__ __device__ __forceinline__ int lds_byte(int r, int c) { const int st = (r >> 4) * 2 + (c >> 5), rr = r & 15, cc = c & 31, ob = rr * 64 + cc * 2; return st * 1024 + (ob ^ (((ob >> 9) & 1) << 5)); }
__host__ __device__ __forceinline__ void stage_rc(int b, int& R, int& C) { const int st = b / 1024, sb = b % 1024, swz = sb ^ (((sb >> 9) & 1) << 5); R = (st >> 1) * 16 + swz / 64; C = (st & 1) * 32 + (swz % 64) / 2; }
__host__ __device__ __forceinline__ int perm32(int rho) { const int n = rho >> 4, i = rho & 15; return 8 * (i >> 2) + 4 * n + (i & 3); }

struct Unit { int pm, pn; };
struct Gemm { const bf16_t* A; const bf16_t* Bt; int M, N, K; };

struct StaticOrder {
    int nM, nN, nwg, G, c;
    __host__ __device__ void init(int M, int N, int G_, int c_) { nM = M / BM; nN = N / BM; nwg = nM * nN; G = G_; c = c_; }
    __host__ __device__ bool next(int i, Unit& u) const {
        const long L = (long)i * G + c; if (L >= nwg) return false;
        int wgid = (int)L; { const int q = nwg / NXCD, r = nwg % NXCD, xcd = wgid % NXCD, off = wgid / NXCD; wgid = (xcd < r ? xcd * (q + 1) : r * (q + 1) + (xcd - r) * q) + off; }
        const int nig = WGM * nN, gid = wgid / nig, fm = gid * WGM, gsz = (nM - fm) < WGM ? (nM - fm) : WGM;
        u.pm = fm + ((wgid % nig) % gsz); u.pn = (wgid % nig) / gsz; return true;
    }
    __device__ __forceinline__ void a_ready(const Unit&) const {}
    __device__ __forceinline__ void done(const Unit&) const {}
};
__device__ __forceinline__ unsigned cvt_pk_bf16(float lo, float hi) { unsigned r; asm volatile("v_cvt_pk_bf16_f32 %0, %1, %2" : "=v"(r) : "v"(lo), "v"(hi)); return r; }
struct EpiStore {
    static constexpr bool PERM = true, AFTER_DRAIN = false;
    bf16_t* O; int ldc;
    __device__ __forceinline__ void operator()(const f32x4 (&acc)[2][2][4][2], const Unit& u, int wr, int wc, int fr, int fq) const {
        const int row0 = u.pm * BM + wr * 64 + fr, col0 = u.pn * BM + wc * 32 + 8 * fq;
#pragma unroll
        for (int ai = 0; ai < 2; ++ai)
#pragma unroll
            for (int m = 0; m < 4; ++m) { bf16_t* rowp = O + (size_t)(row0 + ai * HALF + m * 16) * ldc + col0;
#pragma unroll
                for (int bj = 0; bj < 2; ++bj) { const f32x4 v0 = acc[ai][bj][m][0], v1 = acc[ai][bj][m][1];
                    u32x4 w; w.x = cvt_pk_bf16(v0[0], v0[1]); w.y = cvt_pk_bf16(v0[2], v0[3]); w.z = cvt_pk_bf16(v1[0], v1[1]); w.w = cvt_pk_bf16(v1[2], v1[3]);
                    *(u32x4*)(rowp + bj * HALF) = w; } }
    }
};
__device__ __forceinline__ float silu_f(float x) { return x * __builtin_amdgcn_rcpf(1.f + __expf(-x)); }
struct EpiSwiGLU {
    static constexpr bool PERM = true, AFTER_DRAIN = false;
    bf16_t* O; int ldc;
    __device__ __forceinline__ void operator()(const f32x4 (&acc)[2][2][4][2], const Unit& u, int wr, int wc, int fr, int fq) const {
        const int row0 = u.pm * BM + wr * 64 + fr, col0 = u.pn * HALF + wc * 32 + 8 * fq;
#pragma unroll
        for (int ai = 0; ai < 2; ++ai)
#pragma unroll
            for (int m = 0; m < 4; ++m) { bf16_t* rowp = O + (size_t)(row0 + ai * HALF + m * 16) * ldc + col0;
                const f32x4 g0 = acc[ai][0][m][0], g1 = acc[ai][0][m][1], u0 = acc[ai][1][m][0], u1 = acc[ai][1][m][1];
                u32x4 w;
                w.x = cvt_pk_bf16(silu_f(g0[0]) * u0[0], silu_f(g0[1]) * u0[1]); w.y = cvt_pk_bf16(silu_f(g0[2]) * u0[2], silu_f(g0[3]) * u0[3]);
                w.z = cvt_pk_bf16(silu_f(g1[0]) * u1[0], silu_f(g1[1]) * u1[1]); w.w = cvt_pk_bf16(silu_f(g1[2]) * u1[2], silu_f(g1[3]) * u1[3]);
                *(u32x4*)rowp = w; }
    }
};
template <class Epi, class Sched, bool ALIGN_EPI = false, bool SP2 = false>
__device__ __forceinline__ void gemm_phase(PG8_LAS unsigned char* lds, const Gemm g, const Sched& S, const Epi& E) {
    const int tid = threadIdx.x, wid = __builtin_amdgcn_readfirstlane(tid >> 6), lane = tid & 63, wr = wid >> 2, wc = wid & 3, fr = lane & 15, fq = lane >> 4;
    const int K = g.K, nt = K / BK;
    unsigned voffA[2], voffB[2];
#pragma unroll
    for (int i = 0; i < 2; ++i) { int R, C; stage_rc(tid * 16 + i * 8192, R, C); const int Rb = Epi::PERM ? ((R & ~31) + perm32(R & 31)) : R;
        voffA[i] = (unsigned)(R * K + C) * 2u; voffB[i] = (unsigned)(Rb * K + C) * 2u; }
    const size_t kstep = (size_t)(BK * 2);
    const size_t hstep = (size_t)HALF * K * 2;
    const size_t tstep = 2 * hstep;
    const unsigned ldsw = (unsigned)wid * 1024u;
    const int aoff = lds_byte(wr * 64 + fr, fq * 8), boff = lds_byte(wc * 32 + fr, fq * 8);
#define PG8_SA(b, h) (((b) * 2 + (h)) * HTB)
#define PG8_SB(b, h) ((4 + (b) * 2 + (h)) * HTB)
#define PG8_STAGE(bufoff, gbase, voff) do { _Pragma("unroll") for (int _i = 0; _i < 2; ++_i) \
        __builtin_amdgcn_global_load_lds((const unsigned*)((const char*)(gbase) + (voff)[_i]), (PG8_LAS unsigned*)(lds + (bufoff) + ldsw + _i * 8192), 16, 0, 0); } while (0)
#define PG8_LDA(dst, b, h) do { _Pragma("unroll") for (int m = 0; m < 4; ++m) _Pragma("unroll") for (int k = 0; k < 2; ++k) dst[m][k] = *(const PG8_LAS bf16x8*)(lds + PG8_SA(b, h) + aoff + m * 2048 + k * 1024); } while (0)
#define PG8_LDB(dst, b, h) do { _Pragma("unroll") for (int n = 0; n < 2; ++n) _Pragma("unroll") for (int k = 0; k < 2; ++k) dst[n][k] = *(const PG8_LAS bf16x8*)(lds + PG8_SB(b, h) + boff + n * 2048 + k * 1024); } while (0)
#define PG8_MMA(ai, bj, At, Bt) do { __builtin_amdgcn_s_setprio(1); _Pragma("unroll") for (int m = 0; m < 4; ++m) _Pragma("unroll") for (int n = 0; n < 2; ++n) _Pragma("unroll") for (int k = 0; k < 2; ++k) \
        acc[ai][bj][m][n] = __builtin_amdgcn_mfma_f32_16x16x32_bf16(Bt[n][k], At[m][k], acc[ai][bj][m][n], 0, 0, 0); __builtin_amdgcn_s_setprio(0); } while (0)
#define PG8_WAIT_V(n) asm volatile("s_waitcnt vmcnt(" #n ")" ::: "memory")
#define PG8_WAIT_L(n) asm volatile("s_waitcnt lgkmcnt(" #n ")" ::: "memory")
#define PG8_BAR __builtin_amdgcn_s_barrier()
#define PG8_SCHED __builtin_amdgcn_sched_barrier(0)
    Unit cur, nxt; int ui = 0;
    if (!S.next(0, cur)) return;
    f32x4 acc[2][2][4][2];
#pragma unroll
    for (int a = 0; a < 2; ++a)
#pragma unroll
        for (int b = 0; b < 2; ++b)
#pragma unroll
            for (int m = 0; m < 4; ++m)
#pragma unroll
                for (int n = 0; n < 2; ++n) acc[a][b][m][n] = (f32x4){0.f, 0.f, 0.f, 0.f};
    bf16x8 At[4][2], B0[2][2], B1[2][2];
    const char* cA = (const char*)g.A + (size_t)cur.pm * tstep; const char* cB = (const char*)g.Bt + (size_t)cur.pn * tstep;
    S.a_ready(cur);
    if constexpr (SP2) {
        PG8_STAGE(PG8_SB(0, 0), cB, voffB); PG8_STAGE(PG8_SB(0, 1), cB + hstep, voffB); PG8_STAGE(PG8_SA(0, 0), cA, voffA); PG8_STAGE(PG8_SA(0, 1), cA + hstep, voffA);
        if (wr == 1) PG8_BAR;
        PG8_WAIT_V(2); PG8_BAR;
        PG8_STAGE(PG8_SB(1, 0), cB + kstep, voffB); PG8_STAGE(PG8_SA(1, 0), cA + kstep, voffA); PG8_STAGE(PG8_SB(1, 1), cB + hstep + kstep, voffB);
        PG8_WAIT_V(6); PG8_BAR;
    } else {
        PG8_STAGE(PG8_SB(0, 0), cB, voffB); PG8_STAGE(PG8_SA(0, 0), cA, voffA); PG8_STAGE(PG8_SB(0, 1), cB + hstep, voffB); PG8_STAGE(PG8_SA(0, 1), cA + hstep, voffA);
        if (wr == 1) PG8_BAR;
        PG8_WAIT_V(4); PG8_BAR;
        PG8_STAGE(PG8_SB(1, 0), cB + kstep, voffB); PG8_STAGE(PG8_SA(1, 0), cA + kstep, voffA); PG8_STAGE(PG8_SB(1, 1), cB + hstep + kstep, voffB);
        PG8_WAIT_V(6); PG8_BAR;
    }
    for (;;) {
        const bool has_next = S.next(ui + 1, nxt);
        const char* nA = has_next ? (const char*)g.A + (size_t)nxt.pm * tstep : cA; const char* nB = has_next ? (const char*)g.Bt + (size_t)nxt.pn * tstep : cB;
        for (int t = 0; t < nt; t += 2) {
            const bool last = (t == nt - 2);
            const char* a1 = cA + (size_t)(t + 1) * kstep;
            const char* a2 = last ? nA : cA + (size_t)(t + 2) * kstep; const char* b2 = last ? nB : cB + (size_t)(t + 2) * kstep;
            const char* a3 = a2 + kstep; const char* b3 = b2 + kstep;
            if (last && has_next) S.a_ready(nxt);
            if constexpr (SP2) {
            PG8_LDB(B0, 0, 0); PG8_LDB(B1, 0, 1); PG8_SCHED; PG8_LDA(At, 0, 0); PG8_STAGE(PG8_SA(1, 1), a1 + hstep, voffA);
            PG8_WAIT_V(8); PG8_WAIT_L(0); PG8_BAR; PG8_MMA(0, 0, At, B0); PG8_MMA(0, 1, At, B1); PG8_BAR; PG8_SCHED;
            PG8_LDA(At, 0, 1); PG8_STAGE(PG8_SB(0, 0), b2, voffB); PG8_STAGE(PG8_SB(0, 1), b2 + hstep, voffB); PG8_STAGE(PG8_SA(0, 0), a2, voffA);
            PG8_WAIT_V(8); PG8_WAIT_L(0); PG8_BAR; PG8_MMA(1, 0, At, B0); PG8_MMA(1, 1, At, B1); PG8_BAR; PG8_SCHED;
            PG8_LDB(B0, 1, 0); PG8_LDB(B1, 1, 1); PG8_SCHED; PG8_LDA(At, 1, 0); PG8_STAGE(PG8_SA(0, 1), a2 + hstep, voffA);
            PG8_WAIT_V(8); PG8_WAIT_L(0); PG8_BAR; PG8_MMA(0, 0, At, B0); PG8_MMA(0, 1, At, B1); PG8_BAR; PG8_SCHED;
            PG8_LDA(At, 1, 1); PG8_STAGE(PG8_SB(1, 0), b3, voffB); PG8_STAGE(PG8_SB(1, 1), b3 + hstep, voffB); PG8_STAGE(PG8_SA(1, 0), a3, voffA);
            PG8_WAIT_V(8); PG8_WAIT_L(0); PG8_BAR; PG8_MMA(1, 0, At, B0); PG8_MMA(1, 1, At, B1); PG8_BAR; PG8_SCHED;
            } else {
            PG8_LDB(B0, 0, 0); PG8_SCHED; PG8_LDA(At, 0, 0); PG8_STAGE(PG8_SA(1, 1), a1 + hstep, voffA);
            PG8_WAIT_L(8); PG8_BAR; PG8_WAIT_L(0); PG8_MMA(0, 0, At, B0); PG8_BAR; PG8_SCHED;
            PG8_LDB(B1, 0, 1); PG8_STAGE(PG8_SB(0, 0), b2, voffB);
            PG8_BAR; PG8_WAIT_L(0); PG8_MMA(0, 1, At, B1); PG8_BAR;
            PG8_LDA(At, 0, 1); PG8_STAGE(PG8_SA(0, 0), a2, voffA);
            PG8_BAR; PG8_WAIT_L(0); PG8_MMA(1, 0, At, B0); PG8_BAR; PG8_SCHED;
            PG8_STAGE(PG8_SB(0, 1), b2 + hstep, voffB);
            PG8_WAIT_V(6); PG8_BAR; PG8_MMA(1, 1, At, B1); PG8_BAR;
            PG8_LDB(B0, 1, 0); PG8_SCHED; PG8_LDA(At, 1, 0); PG8_STAGE(PG8_SA(0, 1), a2 + hstep, voffA);
            PG8_WAIT_L(8); PG8_BAR; PG8_WAIT_L(0); PG8_MMA(0, 0, At, B0); PG8_BAR; PG8_SCHED;
            PG8_LDB(B1, 1, 1); PG8_STAGE(PG8_SB(1, 0), b3, voffB);
            PG8_BAR; PG8_WAIT_L(0); PG8_MMA(0, 1, At, B1); PG8_BAR;
            PG8_LDA(At, 1, 1); PG8_STAGE(PG8_SA(1, 0), a3, voffA);
            PG8_BAR; PG8_WAIT_L(0); PG8_MMA(1, 0, At, B0); PG8_BAR; PG8_SCHED;
            PG8_STAGE(PG8_SB(1, 1), b3 + hstep, voffB);
            PG8_WAIT_V(6); PG8_BAR; PG8_MMA(1, 1, At, B1); PG8_BAR;
            }
        }
        if constexpr (ALIGN_EPI) { if (wr == 0) PG8_BAR; }
        if constexpr (!Epi::AFTER_DRAIN) { E(acc, cur, wr, wc, fr, fq); S.done(cur); }
        if (!has_next) break;
#pragma unroll
        for (int a = 0; a < 2; ++a)
#pragma unroll
            for (int b = 0; b < 2; ++b)
#pragma unroll
                for (int m = 0; m < 4; ++m)
#pragma unroll
                    for (int n = 0; n < 2; ++n) acc[a][b][m][n] = (f32x4){0.f, 0.f, 0.f, 0.f};
        cur = nxt; cA = nA; cB = nB; ++ui;
        if constexpr (ALIGN_EPI) { if (wr == 1) PG8_BAR; }
    }
    PG8_WAIT_V(0);
    if constexpr (!ALIGN_EPI) { if (wr == 0) PG8_BAR; }
    PG8_BAR;
    if constexpr (Epi::AFTER_DRAIN) { E.fused(acc, cur, wr, wc, fr, fq, lds, wid, lane); S.done(cur); }
#undef PG8_SA
#undef PG8_SB
#undef PG8_STAGE
#undef PG8_LDA
#undef PG8_LDB
#undef PG8_MMA
#undef PG8_WAIT_V
#undef PG8_WAIT_L
#undef PG8_BAR
#undef PG8_SCHED
}
}

#define GAS __attribute__((address_space(1)))
#define LAS __attribute__((address_space(3)))
typedef unsigned short bf16;
typedef unsigned v4u __attribute__((ext_vector_type(4)));
typedef unsigned v2u __attribute__((ext_vector_type(2)));
typedef float f32x4 __attribute__((ext_vector_type(4)));
typedef short bf16x8 __attribute__((ext_vector_type(8)));
typedef GAS unsigned gu32;
#define RLX_AGENT __ATOMIC_RELAXED, __HIP_MEMORY_SCOPE_AGENT
#define LDS_WAIT() asm volatile("s_waitcnt lgkmcnt(0)" ::: "memory")
#define VM_WAIT() asm volatile("s_waitcnt vmcnt(0)" ::: "memory")
__device__ __forceinline__ unsigned f2bf(float f) { unsigned u = __builtin_bit_cast(unsigned, f); return (u + 0x7fffu + ((u >> 16) & 1u)) >> 16; }
__device__ __forceinline__ unsigned pk2(float lo, float hi) { return f2bf(lo) | (f2bf(hi) << 16); }
#define XB_TMO      128
#define XB_XCNT(j)  (256  + 64 * (j))
#define XB_XSUB(j)  (1280 + 64 * (j))
#define XB_XGEN(j)  (2304 + 64 * (j))
#define XB_TOP      3328
#define XB_TOPGEN   3392
#define XCD_BAR_WORDS 3456
#define XB_SPIN_CAP (1u << 18)

__device__ __forceinline__ unsigned xb_ld(unsigned* p)              { return __hip_atomic_load(p, __ATOMIC_RELAXED, __HIP_MEMORY_SCOPE_AGENT); }
__device__ __forceinline__ unsigned xb_add(unsigned* p, unsigned v) { return __hip_atomic_fetch_add(p, v, __ATOMIC_RELAXED, __HIP_MEMORY_SCOPE_AGENT); }
__device__ __forceinline__ unsigned xb_xcc_id() { return (unsigned)__builtin_amdgcn_s_getreg((3 << 11) | 20) & 0xFu; }
#define XB_SPIN(cond, bar) do { unsigned _sp = 0; while (cond) { __builtin_amdgcn_s_sleep(1); \
    if ((++_sp & 255u) == 0u) { if (xb_ld(&(bar)[XB_TMO])) break; if (_sp > XB_SPIN_CAP) { atomicAdd(&(bar)[XB_TMO], 1u); break; } } } } while (0)

struct XcdBarrier {
    unsigned* bar; unsigned x;
    volatile LAS unsigned* st;
};

__device__ __forceinline__ XcdBarrier xcd_barrier_post(unsigned* bar, volatile LAS unsigned* st) {
    XcdBarrier b; b.bar = bar; b.x = xb_xcc_id(); b.st = st;
    if (threadIdx.x == 0) (void)xb_add(&bar[XB_XCNT(b.x)], 1u);
    return b;
}
__device__ __forceinline__ void xcd_barrier_complete(unsigned* bar, unsigned x, unsigned& nloc, unsigned& nx) {
    const unsigned G = gridDim.x * gridDim.y * gridDim.z;
    unsigned sum, cnt, mine, sp = 0u;
    for (;;) {
        sum = 0u; cnt = 0u; mine = 0u;
#pragma unroll
        for (unsigned j = 0; j < 16; ++j) { const unsigned c = xb_ld(&bar[XB_XCNT(j)]); sum += c; cnt += (c > 0u) ? 1u : 0u; mine = (j == x) ? c : mine; }
        if (sum == G) break;
        __builtin_amdgcn_s_sleep(1);
        if ((++sp & 255u) == 0u) { if (xb_ld(&bar[XB_TMO])) break; if (sp > XB_SPIN_CAP) { atomicAdd(&bar[XB_TMO], 1u); break; } }
    }
    nloc = mine > 0u ? mine : 1u; nx = cnt > 0u ? cnt : 1u;
}

__device__ __forceinline__ void xcd_barrier(const XcdBarrier& b) {
    asm volatile("s_waitcnt vmcnt(0)" ::: "memory");
    __syncthreads();
    if (threadIdx.x == 0) {
        unsigned* bar = b.bar;
        __builtin_amdgcn_s_waitcnt(0);
        unsigned nloc = b.st[0], nx = b.st[1];
        if (nloc == 0u) { xcd_barrier_complete(bar, b.x, nloc, nx); b.st[0] = nloc; b.st[1] = nx; }
        const unsigned old = xb_add(&bar[XB_XSUB(b.x)], 1u);
        const unsigned gen = old / nloc;
        if (old + 1u == (gen + 1u) * nloc) {
            __builtin_amdgcn_fence(__ATOMIC_RELEASE, "agent");
            asm volatile("s_waitcnt vmcnt(0)" ::: "memory");
            const unsigned og = xb_add(&bar[XB_TOP], 1u);
            const unsigned tg = og / nx;
            if (og + 1u == (tg + 1u) * nx) xb_add(&bar[XB_TOPGEN], 1u);
            else XB_SPIN(xb_ld(&bar[XB_TOPGEN]) == tg, bar);
            __builtin_amdgcn_fence(__ATOMIC_ACQUIRE, "agent");
            xb_add(&bar[XB_XGEN(b.x)], 1u);
            asm volatile("s_waitcnt vmcnt(0)" ::: "memory");
        } else {
            XB_SPIN(xb_ld(&bar[XB_XGEN(b.x)]) == gen, bar);
            __builtin_amdgcn_fence(__ATOMIC_ACQUIRE, "agent");
            asm volatile("s_waitcnt vmcnt(0)" ::: "memory");
        }
    }
    __syncthreads();
}

namespace cg = cooperative_groups;
constexpr int NWAVES = 8, NTHR = 512;
constexpr int DM = 1024, NBP = 8, SEQ = 2048, NBS = 128, DSEQ = 8, MP = NBP * SEQ, MS = NBS * DSEQ, MT = MP + MS, NSEQ = NBP + NBS;
constexpr int NIN = 3072, DFF = 2816, NGU = 2 * DFF, NMOD = 6 * DM;
constexpr int ZQ = 0, ZF = 512, ZI = 1024, ZG = 1536, ZU = 2048, ZV = 2560;
constexpr float EPS = 1e-6f;
constexpr size_t O_Y = 0, O_SP = (size_t)MT * DM, O_SS = O_SP + (size_t)NBP * 4 * 16384, O_VP = O_SS + (size_t)NBS * 4 * 16384, O_VS = O_VP + (size_t)NBP * 128 * 512;
constexpr size_t MiB = 1u << 20;
constexpr size_t OUT_QD = 0, OUT_OI = 16 * MiB;
constexpr size_t WS_CTL = 0, CTL_ZERO_BYTES = 64 * 1024;
constexpr size_t WS_WIN = 1 * MiB, WS_WOUT = 7 * MiB, WS_WGU = 9 * MiB, WS_WDN = 20 * MiB, WS_MOD = 26 * MiB, WS_SC = 30 * MiB, WS_DEC = 31 * MiB;
constexpr size_t WS_H = 32 * MiB, WS_Z = 66 * MiB, WS_DS = 168 * MiB, WS_END = 232 * MiB;
constexpr size_t WS_ACT = WS_Z, WS_MB = WS_DS, WS_FB = WS_DS;
static_assert(WS_WDN + (size_t)DM * DFF * 2 <= WS_MOD && WS_MOD + (size_t)NSEQ * NMOD * 4 <= WS_SC && WS_H + (size_t)MT * DM * 2 <= WS_Z && WS_Z + (size_t)MT * NIN * 2 <= WS_DS, "ws map");
static_assert(WS_ACT + (size_t)MT * DFF * 2 <= WS_DS && WS_DS + (size_t)1024 * 16384 * 4 <= WS_END, "ws map 2");
constexpr int CW_BAR = 4096;
constexpr int RING_BYTES = 131072, LDSCTL_OFF = RING_BYTES, MISC_OFF = LDSCTL_OFF + 320, LDS_BYTES = 147456;
constexpr int NPH = 12;
#ifndef MK_N_LAUNCHES
#define MK_N_LAUNCHES 1
#endif

__device__ __forceinline__ float wave_sum(float v) {
#pragma unroll
    for (int o = 1; o < 64; o <<= 1) v += __shfl_xor(v, o);
    return v;
}
__device__ __forceinline__ float bflo(unsigned u) { return __uint_as_float(u << 16); }
__device__ __forceinline__ float bfhi(unsigned u) { return __uint_as_float(u & 0xffff0000u); }
__device__ __forceinline__ float rcp_f(float x) { return __builtin_amdgcn_rcpf(x); }
__device__ __forceinline__ float sigm_f(float x) { return rcp_f(1.f + __expf(-x)); }
__device__ __forceinline__ float silu2_f(float x) { return x * sigm_f(x); }
__device__ __forceinline__ float gelu_f(float x) { return x * sigm_f(1.5957691216057308f * (x + 0.044715f * x * x * x)); }
__device__ __forceinline__ bf16x8 pack8(f32x4 a, f32x4 b) { v4u t; t.x = pg8::cvt_pk_bf16(a[0], a[1]); t.y = pg8::cvt_pk_bf16(a[2], a[3]); t.z = pg8::cvt_pk_bf16(b[0], b[1]); t.w = pg8::cvt_pk_bf16(b[2], b[3]); return __builtin_bit_cast(bf16x8, t); }
#define MFMA16(a, b, c) __builtin_amdgcn_mfma_f32_16x16x32_bf16((a), (b), (c), 0, 0, 0)

struct Args { const float* in[22]; float* out; unsigned char* ws; int ph_lo, ph_hi, use_cg, pad; };
struct Ctx { LAS unsigned char* lds; int tid, lane, wave, vcu, G; };

__device__ __forceinline__ void transpose_item(const float* W, int K, int N, bf16* WT, int kb, int n0, int drow0, LAS float* scr, int lane) {
    const int k0 = 64 * kb;
#pragma unroll 8
    for (int i = 0; i < 32; ++i) { const int kk = 2 * i + (lane >> 5); scr[kk * 33 + (lane & 31)] = W[(size_t)(k0 + kk) * N + n0 + (lane & 31)]; }
    LDS_WAIT(); asm volatile("" ::: "memory");
    const int c = lane & 7;
#pragma unroll
    for (int j = 0; j < 4; ++j) { const int n = (lane >> 3) + 8 * j; const LAS float* s = scr + (8 * c) * 33 + n;
        v4u o; o.x = pk2(s[0 * 33], s[1 * 33]); o.y = pk2(s[2 * 33], s[3 * 33]); o.z = pk2(s[4 * 33], s[5 * 33]); o.w = pk2(s[6 * 33], s[7 * 33]);
        *(v4u*)(WT + (size_t)(drow0 + n) * K + k0 + 8 * c) = o; }
    LDS_WAIT(); asm volatile("" ::: "memory");
}
__device__ __forceinline__ void phase_p0(const Args& a, const Ctx& C) {
    unsigned char* ws = a.ws;
    { bf16* SC = (bf16*)(ws + WS_SC); const float* cp = a.in[3]; const float* cs = a.in[4];
      for (int e = C.vcu * NTHR + C.tid; e < 144 * DM; e += C.G * NTHR) { const int r = e >> 10; float v = 0.f;
          if (r < NBP) v = silu2_f(cp[e]); else if (r < NSEQ) v = silu2_f(cs[e - NBP * DM]);
          SC[e] = (bf16)f2bf(v); } }
    LAS float* scr = (LAS float*)(C.lds + C.wave * 16384);
    const int gw = C.vcu * NWAVES + C.wave, NGW = C.G * NWAVES;
    constexpr int I_IN = 16 * 96, I_OUT = 16 * 32, I_G = 16 * 88, I_D = 44 * 32, NITEMS = I_IN + I_OUT + 2 * I_G + I_D;
    for (int it = gw; it < NITEMS; it += NGW) {
        int r = it;
        if (r < I_IN) { const int kb = r / 96, n0 = 32 * (r % 96); transpose_item(a.in[10], DM, NIN, (bf16*)(ws + WS_WIN), kb, n0, n0, scr, C.lane); continue; } r -= I_IN;
        if (r < I_OUT) { const int kb = r / 32, n0 = 32 * (r % 32); transpose_item(a.in[16], DM, DM, (bf16*)(ws + WS_WOUT), kb, n0, n0, scr, C.lane); continue; } r -= I_OUT;
        if (r < I_G) { const int kb = r / 88, n0 = 32 * (r % 88); transpose_item(a.in[19], DM, DFF, (bf16*)(ws + WS_WGU), kb, n0, 256 * (n0 >> 7) + (n0 & 127), scr, C.lane); continue; } r -= I_G;
        if (r < I_G) { const int kb = r / 88, n0 = 32 * (r % 88); transpose_item(a.in[20], DM, DFF, (bf16*)(ws + WS_WGU), kb, n0, 256 * (n0 >> 7) + 128 + (n0 & 127), scr, C.lane); continue; } r -= I_G;
        { const int kb = r / 32, n0 = 32 * (r % 32); transpose_item(a.in[21], DFF, DM, (bf16*)(ws + WS_WDN), kb, n0, n0, scr, C.lane); }
    }
}
__device__ __forceinline__ void phase_mod(const Args& a, const Ctx& C) {
    const bf16* SC = (const bf16*)(a.ws + WS_SC); const float* wada = a.in[6]; const float* bada = a.in[7]; float* MOD = (float*)(a.ws + WS_MOD);
    const int i = C.lane & 15, kq = C.lane >> 4;
    for (int it = C.wave * C.G + C.vcu; it < NMOD / 16; it += C.G * NWAVES) {
        const int n0 = it * 16;
        f32x4 acc[9];
#pragma unroll
        for (int rb = 0; rb < 9; ++rb) acc[rb] = (f32x4){0.f, 0.f, 0.f, 0.f};
#pragma unroll 2
        for (int ks = 0; ks < 32; ++ks) {
            const int k0 = ks * 32 + kq * 8;
            const float* wp = wada + (size_t)k0 * NMOD + n0 + i;
            f32x4 w0, w1;
            w0[0] = wp[0]; w0[1] = wp[(size_t)NMOD]; w0[2] = wp[(size_t)2 * NMOD]; w0[3] = wp[(size_t)3 * NMOD];
            w1[0] = wp[(size_t)4 * NMOD]; w1[1] = wp[(size_t)5 * NMOD]; w1[2] = wp[(size_t)6 * NMOD]; w1[3] = wp[(size_t)7 * NMOD];
            const bf16x8 af = pack8(w0, w1);
#pragma unroll
            for (int rb = 0; rb < 9; ++rb) { const bf16x8 bfr = *(const bf16x8*)(SC + (size_t)(rb * 16 + i) * DM + k0); acc[rb] = MFMA16(af, bfr, acc[rb]); }
        }
        const int n = n0 + kq * 4; const f32x4 bias = *(const f32x4*)(bada + n);
#pragma unroll
        for (int rb = 0; rb < 9; ++rb) { const int r = rb * 16 + i; if (r < NSEQ) *(f32x4*)(MOD + (size_t)r * NMOD + n) = acc[rb] + bias; }
    }
}
__device__ __forceinline__ const float* xrow_ptr(const Args& a, int m) { return m < MP ? a.in[0] + (size_t)m * DM : a.in[1] + (size_t)(m - MP) * DM; }
__device__ __forceinline__ int seq_of(int m) { return m < MP ? (m >> 11) : NBP + ((m - MP) >> 3); }
__device__ __forceinline__ void store4bf(bf16* p, f32x4 v) { v2u o; o.x = pg8::cvt_pk_bf16(v[0], v[1]); o.y = pg8::cvt_pk_bf16(v[2], v[3]); *(v2u*)p = o; }
__device__ __forceinline__ f32x4 load4bf(const bf16* p) { const v2u w = *(const v2u*)p; return (f32x4){bflo(w.x), bfhi(w.x), bflo(w.y), bfhi(w.y)}; }
__device__ __forceinline__ void phase_p1(const Args& a, const Ctx& C) {
    const float* MOD = (const float*)(a.ws + WS_MOD); bf16* H = (bf16*)(a.ws + WS_H); const float* npm = a.in[8];
    for (int m = C.vcu * NWAVES + C.wave; m < MT; m += C.G * NWAVES) {
        const float* xr = xrow_ptr(a, m); const float* md = MOD + (size_t)seq_of(m) * NMOD;
        f32x4 v[4]; float ss = 0.f;
#pragma unroll
        for (int j = 0; j < 4; ++j) { v[j] = *(const f32x4*)(xr + 4 * C.lane + 256 * j); ss += (v[j][0] * v[j][0] + v[j][1] * v[j][1]) + (v[j][2] * v[j][2] + v[j][3] * v[j][3]); }
        const float rs = rsqrtf(wave_sum(ss) * (1.f / DM) + EPS);
#pragma unroll
        for (int j = 0; j < 4; ++j) { const int c = 4 * C.lane + 256 * j;
            const f32x4 g = *(const f32x4*)(npm + c), sh = *(const f32x4*)(md + c), sc = *(const f32x4*)(md + DM + c);
            store4bf(H + (size_t)m * DM + c, v[j] * rs * g * (sc + 1.f) + sh); }
    }
}
__device__ __forceinline__ void phase_p5(const Args& a, const Ctx& C) {
    const float* MOD = (const float*)(a.ws + WS_MOD); bf16* H = (bf16*)(a.ws + WS_H); const bf16* MB = (const bf16*)(a.ws + WS_MB);
    const float* npost = a.in[9]; const float* npre = a.in[17];
    for (int m = C.vcu * NWAVES + C.wave; m < MT; m += C.G * NWAVES) {
        const float* xr = xrow_ptr(a, m); const float* md = MOD + (size_t)seq_of(m) * NMOD;
        f32x4 mv[4]; float ss = 0.f;
#pragma unroll
        for (int j = 0; j < 4; ++j) { mv[j] = load4bf(MB + (size_t)m * DM + 4 * C.lane + 256 * j); ss += (mv[j][0] * mv[j][0] + mv[j][1] * mv[j][1]) + (mv[j][2] * mv[j][2] + mv[j][3] * mv[j][3]); }
        const float rs = rsqrtf(wave_sum(ss) * (1.f / DM) + EPS);
        f32x4 x1[4]; float ss2 = 0.f;
#pragma unroll
        for (int j = 0; j < 4; ++j) { const int c = 4 * C.lane + 256 * j;
            const f32x4 xv = *(const f32x4*)(xr + c), g = *(const f32x4*)(npost + c), g1 = *(const f32x4*)(md + 2 * DM + c);
            x1[j] = xv + g1 * (mv[j] * rs * g);
            *(f32x4*)(a.out + O_Y + (size_t)m * DM + c) = x1[j];
            ss2 += (x1[j][0] * x1[j][0] + x1[j][1] * x1[j][1]) + (x1[j][2] * x1[j][2] + x1[j][3] * x1[j][3]); }
        const float rs2 = rsqrtf(wave_sum(ss2) * (1.f / DM) + EPS);
#pragma unroll
        for (int j = 0; j < 4; ++j) { const int c = 4 * C.lane + 256 * j;
            const f32x4 g = *(const f32x4*)(npre + c), sh = *(const f32x4*)(md + 3 * DM + c), sc = *(const f32x4*)(md + 4 * DM + c);
            store4bf(H + (size_t)m * DM + c, x1[j] * rs2 * g * (sc + 1.f) + sh); }
    }
}
__device__ __forceinline__ void phase_p8(const Args& a, const Ctx& C) {
    const float* MOD = (const float*)(a.ws + WS_MOD); const bf16* FB = (const bf16*)(a.ws + WS_FB); const float* npf = a.in[18];
    for (int m = C.vcu * NWAVES + C.wave; m < MT; m += C.G * NWAVES) {
        const float* md = MOD + (size_t)seq_of(m) * NMOD;
        f32x4 fv[4]; float ss = 0.f;
#pragma unroll
        for (int j = 0; j < 4; ++j) { fv[j] = load4bf(FB + (size_t)m * DM + 4 * C.lane + 256 * j); ss += (fv[j][0] * fv[j][0] + fv[j][1] * fv[j][1]) + (fv[j][2] * fv[j][2] + fv[j][3] * fv[j][3]); }
        const float rs = rsqrtf(wave_sum(ss) * (1.f / DM) + EPS);
#pragma unroll
        for (int j = 0; j < 4; ++j) { const int c = 4 * C.lane + 256 * j; float* op = a.out + O_Y + (size_t)m * DM + c;
            const f32x4 x1 = *(const f32x4*)op, g = *(const f32x4*)(npf + c), g2 = *(const f32x4*)(md + 5 * DM + c);
            *(f32x4*)op = x1 + g2 * (fv[j] * rs * g); }
    }
}
constexpr int A_LF = 0, A_LFS = 132, A_PT = 33792, A_QD = 35840, A_KD = 53248, A_KET = 70656, A_VT = 89088, A_PP = 107520, A_LB = 116736;
__device__ __forceinline__ void unpack16(const v4u a, const v4u b, float (&z)[16]) {
    z[0] = bflo(a.x); z[1] = bfhi(a.x); z[2] = bflo(a.y); z[3] = bfhi(a.y); z[4] = bflo(a.z); z[5] = bfhi(a.z); z[6] = bflo(a.w); z[7] = bfhi(a.w);
    z[8] = bflo(b.x); z[9] = bfhi(b.x); z[10] = bflo(b.y); z[11] = bfhi(b.y); z[12] = bflo(b.z); z[13] = bfhi(b.z); z[14] = bflo(b.w); z[15] = bfhi(b.w);
}
__device__ __forceinline__ void hgrn_pass_a(const Args& a, const Ctx& C, int item) {
    const bf16* Z = (const bf16*)(a.ws + WS_Z); float* DS = (float*)(a.ws + WS_DS); float* DEC = (float*)(a.ws + WS_DEC);
    bf16* QDG = (bf16*)((unsigned char*)a.out + OUT_QD); float* OI = (float*)((unsigned char*)a.out + OUT_OI);
    const float* lbl = a.in[5];
    const int bh = item >> 5, n = item & 31, b = bh >> 2, h = bh & 3, tok0 = b * SEQ + n * 64;
    LAS unsigned char* lds = C.lds; LAS float* LF = (LAS float*)(lds + A_LF); LAS float* PT = (LAS float*)(lds + A_PT); LAS float* LB = (LAS float*)(lds + A_LB);
    const int tid = C.tid, w = C.wave, i = C.lane & 15, kq = C.lane >> 4;
    if (tid < 128) { const float l0 = lbl[h * 128 + tid], l1 = lbl[512 + h * 128 + tid]; LB[tid] = rcp_f(1.f + __expf(l1 - l0)); }
    __syncthreads();
    const int t = tid >> 3, c0 = (tid & 7) * 16;
    const bf16* zrow = Z + (size_t)(tok0 + t) * NIN + h * 128 + c0;
    float kk[16];
    { const v4u f0 = *(const v4u*)(zrow + ZF), f1 = *(const v4u*)(zrow + ZF + 8); float z[16]; unpack16(f0, f1, z);
#pragma unroll
      for (int j = 0; j < 16; ++j) { const float lb = LB[c0 + j], sg = sigm_f(z[j]); const float f = lb + (1.f - lb) * sg; kk[j] = (1.f - lb) * (1.f - sg); LF[t * A_LFS + c0 + j] = __logf(f); } }
    __syncthreads();
    { const int k = tid & 127, part = tid >> 7; float run = 0.f;
#pragma unroll
      for (int r = 0; r < 16; ++r) { LAS float* p = LF + (part * 16 + r) * A_LFS + k; run += *p; *p = run; }
      PT[part * 128 + k] = run; }
    __syncthreads();
    { const int k = tid & 127, part = tid >> 7;
      const float off = (part > 0 ? PT[k] : 0.f) + (part > 1 ? PT[128 + k] : 0.f) + (part > 2 ? PT[256 + k] : 0.f);
      if (part > 0) {
#pragma unroll
          for (int r = 0; r < 16; ++r) LF[(part * 16 + r) * A_LFS + k] += off; } }
    __syncthreads();
    { const v4u q0 = *(const v4u*)(zrow + ZQ), q1 = *(const v4u*)(zrow + ZQ + 8), i0 = *(const v4u*)(zrow + ZI), i1 = *(const v4u*)(zrow + ZI + 8);
      float q[16]; unpack16(q0, q1, q);
      float qd[16], kd[16], ke[16];
#pragma unroll
      for (int j = 0; j < 16; ++j) { const float bb = LF[t * A_LFS + c0 + j], bl = LF[63 * A_LFS + c0 + j];
          qd[j] = q[j] * __expf(bb); kd[j] = kk[j] * __expf(-bb); ke[j] = kk[j] * __expf(bl - bb);
          if (t == 63) DEC[(size_t)item * 128 + c0 + j] = __expf(bl); }
      v4u o0, o1;
      o0.x = pg8::cvt_pk_bf16(qd[0], qd[1]); o0.y = pg8::cvt_pk_bf16(qd[2], qd[3]); o0.z = pg8::cvt_pk_bf16(qd[4], qd[5]); o0.w = pg8::cvt_pk_bf16(qd[6], qd[7]);
      o1.x = pg8::cvt_pk_bf16(qd[8], qd[9]); o1.y = pg8::cvt_pk_bf16(qd[10], qd[11]); o1.z = pg8::cvt_pk_bf16(qd[12], qd[13]); o1.w = pg8::cvt_pk_bf16(qd[14], qd[15]);
      *(LAS v4u*)(lds + A_QD + t * 272 + c0 * 2) = o0; *(LAS v4u*)(lds + A_QD + t * 272 + c0 * 2 + 16) = o1;
      bf16* qg = QDG + (size_t)(tok0 + t) * 512 + h * 128 + c0; *(v4u*)qg = o0; *(v4u*)(qg + 8) = o1;
      o0.x = pg8::cvt_pk_bf16(kd[0], kd[1]); o0.y = pg8::cvt_pk_bf16(kd[2], kd[3]); o0.z = pg8::cvt_pk_bf16(kd[4], kd[5]); o0.w = pg8::cvt_pk_bf16(kd[6], kd[7]);
      o1.x = pg8::cvt_pk_bf16(kd[8], kd[9]); o1.y = pg8::cvt_pk_bf16(kd[10], kd[11]); o1.z = pg8::cvt_pk_bf16(kd[12], kd[13]); o1.w = pg8::cvt_pk_bf16(kd[14], kd[15]);
      *(LAS v4u*)(lds + A_KD + t * 272 + c0 * 2) = o0; *(LAS v4u*)(lds + A_KD + t * 272 + c0 * 2 + 16) = o1;
      const unsigned vi[8] = {i0.x, i0.y, i0.z, i0.w, i1.x, i1.y, i1.z, i1.w};
#pragma unroll
      for (int j = 0; j < 16; ++j) {
          *(LAS unsigned short*)(lds + A_KET + (c0 + j) * 144 + t * 2) = (unsigned short)f2bf(ke[j]);
          *(LAS unsigned short*)(lds + A_VT + (c0 + j) * 144 + t * 2) = (unsigned short)((j & 1) ? (vi[j >> 1] >> 16) : (vi[j >> 1] & 0xffffu)); } }
    __syncthreads();
    { const int tb = w >> 1;
#pragma unroll
      for (int e = 0; e < 2; ++e) { const int sb = 2 * (w & 1) + e; f32x4 acc = (f32x4){0.f, 0.f, 0.f, 0.f};
#pragma unroll
          for (int ks = 0; ks < 4; ++ks) { const bf16x8 A = *(const LAS bf16x8*)(lds + A_KD + (16 * sb + i) * 272 + (ks * 32 + kq * 8) * 2), B = *(const LAS bf16x8*)(lds + A_QD + (16 * tb + i) * 272 + (ks * 32 + kq * 8) * 2);
              acc = MFMA16(A, B, acc); }
          const int tt = 16 * tb + i, s0 = 16 * sb + kq * 4;
          v2u o; o.x = pg8::cvt_pk_bf16(s0 <= tt ? acc[0] : 0.f, s0 + 1 <= tt ? acc[1] : 0.f); o.y = pg8::cvt_pk_bf16(s0 + 2 <= tt ? acc[2] : 0.f, s0 + 3 <= tt ? acc[3] : 0.f);
          *(LAS v2u*)(lds + A_PP + tt * 144 + s0 * 2) = o; } }
    { bf16x8 A2[2];
#pragma unroll
      for (int sc = 0; sc < 2; ++sc) A2[sc] = *(const LAS bf16x8*)(lds + A_KET + (16 * w + i) * 144 + (sc * 32 + kq * 8) * 2);
#pragma unroll
      for (int vb = 0; vb < 8; ++vb) { f32x4 acc = (f32x4){0.f, 0.f, 0.f, 0.f};
#pragma unroll
          for (int sc = 0; sc < 2; ++sc) { const bf16x8 B = *(const LAS bf16x8*)(lds + A_VT + (16 * vb + i) * 144 + (sc * 32 + kq * 8) * 2); acc = MFMA16(A2[sc], B, acc); }
          *(f32x4*)(DS + (size_t)item * 16384 + (16 * vb + i) * 128 + 16 * w + kq * 4) = acc; } }
    __syncthreads();
    { bf16x8 A3[2];
#pragma unroll
      for (int sc = 0; sc < 2; ++sc) A3[sc] = *(const LAS bf16x8*)(lds + A_VT + (16 * w + i) * 144 + (sc * 32 + kq * 8) * 2);
#pragma unroll
      for (int tb = 0; tb < 4; ++tb) { f32x4 acc = (f32x4){0.f, 0.f, 0.f, 0.f};
#pragma unroll
          for (int sc = 0; sc < 2; ++sc) { const bf16x8 B = *(const LAS bf16x8*)(lds + A_PP + (16 * tb + i) * 144 + (sc * 32 + kq * 8) * 2); acc = MFMA16(A3[sc], B, acc); }
          *(f32x4*)(OI + (size_t)(tok0 + 16 * tb + i) * 512 + h * 128 + 16 * w + kq * 4) = acc; } }
    __syncthreads();
}
__device__ __forceinline__ void hgrn_sample(const Args& a, const Ctx& C, int item) {
    const bf16* Z = (const bf16*)(a.ws + WS_Z); bf16* H = (bf16*)(a.ws + WS_H); const float* lbl = a.in[5]; const float* gnw = a.in[11];
    const int b = item >> 2, h = item & 3, m0 = MP + b * DSEQ, tid = C.tid;
    LAS float* F8 = (LAS float*)C.lds; LAS float* K8 = F8 + 1024; LAS float* Q8 = F8 + 2048; LAS float* V8 = F8 + 3072; LAS float* OP = F8 + 4096;
    for (int idx = tid; idx < 1024; idx += NTHR) { const int t = idx >> 7, k = idx & 127; const bf16* zr = Z + (size_t)(m0 + t) * NIN + h * 128 + k;
        const float l0 = lbl[h * 128 + k], l1 = lbl[512 + h * 128 + k], lb = rcp_f(1.f + __expf(l1 - l0));
        const float sg = sigm_f(bflo(zr[ZF])); F8[idx] = lb + (1.f - lb) * sg; K8[idx] = (1.f - lb) * (1.f - sg); Q8[idx] = bflo(zr[ZQ]); V8[idx] = bflo(zr[ZI]); }
    __syncthreads();
    const int v = tid & 127, kp = tid >> 7;
    const size_t sbase = ((size_t)item * 128 + kp * 32) * 128 + v;
    const float* s0 = a.in[2] + sbase;
    float S[32];
#pragma unroll
    for (int r = 0; r < 32; ++r) S[r] = s0[(size_t)r * 128];
#pragma unroll 1
    for (int t = 0; t < DSEQ; ++t) { const float vt = V8[t * 128 + v]; float o = 0.f;
#pragma unroll
        for (int r4 = 0; r4 < 8; ++r4) { const f32x4 f = *(const LAS f32x4*)(F8 + t * 128 + kp * 32 + r4 * 4), kx = *(const LAS f32x4*)(K8 + t * 128 + kp * 32 + r4 * 4), qx = *(const LAS f32x4*)(Q8 + t * 128 + kp * 32 + r4 * 4);
#pragma unroll
            for (int e = 0; e < 4; ++e) { S[r4 * 4 + e] = f[e] * S[r4 * 4 + e] + kx[e] * vt; o += S[r4 * 4 + e] * qx[e]; } }
        OP[(t * 4 + kp) * 128 + v] = o; }
    float* so = a.out + O_SS + sbase;
#pragma unroll
    for (int r = 0; r < 32; ++r) so[(size_t)r * 128] = S[r];
    __syncthreads();
    { const int t = C.wave, l = C.lane;
      const float o0 = (OP[(t * 4 + 0) * 128 + l] + OP[(t * 4 + 1) * 128 + l]) + (OP[(t * 4 + 2) * 128 + l] + OP[(t * 4 + 3) * 128 + l]);
      const float o1 = (OP[(t * 4 + 0) * 128 + 64 + l] + OP[(t * 4 + 1) * 128 + 64 + l]) + (OP[(t * 4 + 2) * 128 + 64 + l] + OP[(t * 4 + 3) * 128 + 64 + l]);
      const float rs = rsqrtf(wave_sum(o0 * o0 + o1 * o1) * (1.f / 128.f) + EPS);
      const bf16* zg = Z + (size_t)(m0 + t) * NIN + ZG + h * 128; bf16* hp = H + (size_t)(m0 + t) * DM + h * 128;
      hp[l] = (bf16)f2bf(o0 * rs * gnw[l] * silu2_f(bflo(zg[l]))); hp[64 + l] = (bf16)f2bf(o1 * rs * gnw[64 + l] * silu2_f(bflo(zg[64 + l]))); }
    __syncthreads();
}
__device__ __forceinline__ void cmlp_prompt(const Args& a, const Ctx& C, int item) {
    const bf16* Z = (const bf16*)(a.ws + WS_Z); bf16* H = (bf16*)(a.ws + WS_H);
    const float* lng = a.in[12]; const float* lnb = a.in[13]; const float* wsp = a.in[14]; const float* bsp = a.in[15];
    const int g = item & 3, c = (item >> 2) & 15, b = item >> 6, tok0 = b * SEQ + c * 128;
    LAS unsigned char* lds = C.lds; const int tid = C.tid, w = C.wave, i = C.lane & 15, kq = C.lane >> 4;
    { const int s = tid >> 2, part = tid & 3;
      const bf16* zr = Z + (size_t)(tok0 + s) * NIN + ZV + part * 128; float s1 = 0.f, s2 = 0.f;
#pragma unroll 4
      for (int q = 0; q < 16; ++q) { const v4u wv = *(const v4u*)(zr + q * 8); const unsigned u4[4] = {wv.x, wv.y, wv.z, wv.w};
#pragma unroll
          for (int e = 0; e < 4; ++e) { const float x0 = gelu_f(bflo(u4[e])), x1 = gelu_f(bfhi(u4[e])); s1 += x0 + x1; s2 += x0 * x0 + x1 * x1; } }
      s1 += __shfl_xor(s1, 1); s2 += __shfl_xor(s2, 1); s1 += __shfl_xor(s1, 2); s2 += __shfl_xor(s2, 2);
      const float mean = s1 * (1.f / 512.f), var = fmaxf(s2 * (1.f / 512.f) - mean * mean, 0.f), rstd = rsqrtf(var + EPS);
      const bf16* zr2 = Z + (size_t)(tok0 + s) * NIN + ZV + g * 128 + part * 32;
      float* vout = a.out + O_VP + ((size_t)(b * 128 + s)) * 512 + g * 128 + part * 32;
#pragma unroll
      for (int q = 0; q < 4; ++q) { const v4u wv = *(const v4u*)(zr2 + q * 8); const unsigned u4[4] = {wv.x, wv.y, wv.z, wv.w};
          const int d0 = part * 32 + q * 8; float vv[8];
#pragma unroll
          for (int e = 0; e < 4; ++e) { vv[2 * e] = gelu_f(bflo(u4[e])); vv[2 * e + 1] = gelu_f(bfhi(u4[e])); }
          const f32x4 ga = *(const f32x4*)(lng + g * 128 + d0), gb = *(const f32x4*)(lng + g * 128 + d0 + 4), ba = *(const f32x4*)(lnb + g * 128 + d0), bb = *(const f32x4*)(lnb + g * 128 + d0 + 4);
#pragma unroll
          for (int e = 0; e < 8; ++e) { vv[e] = (vv[e] - mean) * rstd * (e < 4 ? ga[e & 3] : gb[e & 3]) + (e < 4 ? ba[e & 3] : bb[e & 3]);
              *(LAS unsigned short*)(lds + (d0 + e) * 272 + s * 2) = (unsigned short)f2bf(vv[e]); }
          if (c == 15) { *(f32x4*)(vout + q * 8) = (f32x4){vv[0], vv[1], vv[2], vv[3]}; *(f32x4*)(vout + q * 8 + 4) = (f32x4){vv[4], vv[5], vv[6], vv[7]}; } } }
    __syncthreads();
    { f32x4 acc[8];
#pragma unroll
      for (int db = 0; db < 8; ++db) acc[db] = (f32x4){0.f, 0.f, 0.f, 0.f};
      const int t = 16 * w + i, nks = (w >> 1) + 1;
      const float* wr = wsp + (size_t)g * 16384 + (size_t)t * 128 + kq * 8;
      for (int ks = 0; ks < nks; ++ks) { f32x4 b0 = *(const f32x4*)(wr + ks * 32), b1 = *(const f32x4*)(wr + ks * 32 + 4); const int sb = ks * 32 + kq * 8;
#pragma unroll
          for (int e = 0; e < 4; ++e) { b0[e] = (sb + e <= t) ? b0[e] : 0.f; b1[e] = (sb + 4 + e <= t) ? b1[e] : 0.f; }
          const bf16x8 B = pack8(b0, b1);
#pragma unroll
          for (int db = 0; db < 8; ++db) { const bf16x8 A = *(const LAS bf16x8*)(lds + (16 * db + i) * 272 + (ks * 32 + kq * 8) * 2); acc[db] = MFMA16(A, B, acc[db]); } }
      const float bs = bsp[g * 128 + t];
      const bf16* zu = Z + (size_t)(tok0 + t) * NIN + ZU + g * 128 + kq * 4; bf16* hp = H + (size_t)(tok0 + t) * DM + 512 + g * 128 + kq * 4;
#pragma unroll
      for (int db = 0; db < 8; ++db) { const f32x4 u = load4bf(zu + 16 * db);
          store4bf(hp + 16 * db, (f32x4){gelu_f(u[0]) * (acc[db][0] + bs), gelu_f(u[1]) * (acc[db][1] + bs), gelu_f(u[2]) * (acc[db][2] + bs), gelu_f(u[3]) * (acc[db][3] + bs)}); } }
    __syncthreads();
}
__device__ __forceinline__ void cmlp_sample(const Args& a, const Ctx& C, int b) {
    const bf16* Z = (const bf16*)(a.ws + WS_Z); bf16* H = (bf16*)(a.ws + WS_H);
    const float* lng = a.in[12]; const float* lnb = a.in[13]; const float* wsp = a.in[14]; const float* bsp = a.in[15];
    const int m0 = MP + b * DSEQ, col = C.tid, g = col >> 7;
    LAS float* RED = (LAS float*)C.lds;
    float x[8];
#pragma unroll
    for (int t = 0; t < 8; ++t) x[t] = gelu_f(bflo(Z[(size_t)(m0 + t) * NIN + ZV + col]));
#pragma unroll
    for (int t = 0; t < 8; ++t) { const float s1 = wave_sum(x[t]), s2 = wave_sum(x[t] * x[t]); if (C.lane == 0) { RED[C.wave * 16 + t] = s1; RED[C.wave * 16 + 8 + t] = s2; } }
    __syncthreads();
    const float lg = lng[col], lb = lnb[col];
    float v[8];
#pragma unroll
    for (int t = 0; t < 8; ++t) { float s1 = 0.f, s2 = 0.f;
#pragma unroll
        for (int ww = 0; ww < 8; ++ww) { s1 += RED[ww * 16 + t]; s2 += RED[ww * 16 + 8 + t]; }
        const float mean = s1 * (1.f / 512.f), var = fmaxf(s2 * (1.f / 512.f) - mean * mean, 0.f), rstd = rsqrtf(var + EPS);
        v[t] = (x[t] - mean) * rstd * lg + lb;
        a.out[O_VS + ((size_t)(b * DSEQ + t)) * 512 + col] = v[t]; }
#pragma unroll
    for (int t = 0; t < 8; ++t) { float mix = bsp[g * 128 + t];
#pragma unroll
        for (int s = 0; s <= t; ++s) mix += wsp[(size_t)g * 16384 + t * 128 + s] * v[s];
        const float u = gelu_f(bflo(Z[(size_t)(m0 + t) * NIN + ZU + col]));
        H[(size_t)(m0 + t) * DM + 512 + col] = (bf16)f2bf(u * mix); }
    __syncthreads();
}
__device__ __forceinline__ void phase_m1(const Args& a, const Ctx& C) {
    constexpr int N_A = NBP * 4 * 32, N_S = NBS * 4, N_C = NBP * 16 * 4, N_D = NBS;
    for (int it = C.vcu; it < N_A + N_S + N_C + N_D; it += C.G) {
        if (it < N_A) hgrn_pass_a(a, C, it);
        else if (it < N_A + N_S) hgrn_sample(a, C, it - N_A);
        else if (it < N_A + N_S + N_C) cmlp_prompt(a, C, it - N_A - N_S);
        else cmlp_sample(a, C, it - N_A - N_S - N_C);
    }
}
__device__ __forceinline__ void phase_m2(const Args& a, const Ctx& C) {
    float* DS = (float*)(a.ws + WS_DS); const float* DEC = (const float*)(a.ws + WS_DEC);
    for (int e = C.vcu * NTHR + C.tid; e < 32 * 4096; e += C.G * NTHR) {
        const int bh = e >> 12, idx = e & 4095, v = idx >> 5, k4 = (idx & 31) * 4;
        f32x4 S = (f32x4){0.f, 0.f, 0.f, 0.f};
        float* p = DS + (size_t)bh * 32 * 16384 + v * 128 + k4; const float* dp = DEC + (size_t)bh * 32 * 128 + k4;
#pragma unroll 8
        for (int n = 0; n < 32; ++n) { const f32x4 ds = *(const f32x4*)(p + (size_t)n * 16384), dc = *(const f32x4*)(dp + n * 128);
            *(f32x4*)(p + (size_t)n * 16384) = S; S = dc * S + ds; }
        float* so = a.out + O_SP + (size_t)bh * 16384 + v;
#pragma unroll
        for (int c = 0; c < 4; ++c) so[(size_t)(k4 + c) * 128] = S[c];
    }
}
__device__ __forceinline__ void hgrn_pass_c(const Args& a, const Ctx& C, int item) {
    const bf16* Z = (const bf16*)(a.ws + WS_Z); bf16* H = (bf16*)(a.ws + WS_H); const float* DS = (const float*)(a.ws + WS_DS);
    const bf16* QDG = (const bf16*)((unsigned char*)a.out + OUT_QD); const float* OI = (const float*)((unsigned char*)a.out + OUT_OI); const float* gnw = a.in[11];
    const int bh = item >> 5, n = item & 31, b = bh >> 2, h = bh & 3, tok0 = b * SEQ + n * 64;
    const int w = C.wave, tb = w & 3, vh = w >> 2, i = C.lane & 15, kq = C.lane >> 4;
    f32x4 acc[4];
#pragma unroll
    for (int vb = 0; vb < 4; ++vb) acc[vb] = (f32x4){0.f, 0.f, 0.f, 0.f};
    const int t = 16 * tb + i;
    const bf16* qp = QDG + (size_t)(tok0 + t) * 512 + h * 128 + kq * 8;
    const float* sp = DS + (size_t)item * 16384 + (size_t)(64 * vh + i) * 128 + kq * 8;
#pragma unroll
    for (int ks = 0; ks < 4; ++ks) { const bf16x8 B = *(const bf16x8*)(qp + ks * 32);
#pragma unroll
        for (int vb = 0; vb < 4; ++vb) { const float* p = sp + vb * 16 * 128 + ks * 32; const bf16x8 A = pack8(*(const f32x4*)p, *(const f32x4*)(p + 4)); acc[vb] = MFMA16(A, B, acc[vb]); } }
    float ss = 0.f; f32x4 o[4];
#pragma unroll
    for (int vb = 0; vb < 4; ++vb) { const int v0 = 64 * vh + 16 * vb + kq * 4; o[vb] = acc[vb] + *(const f32x4*)(OI + (size_t)(tok0 + t) * 512 + h * 128 + v0);
        ss += (o[vb][0] * o[vb][0] + o[vb][1] * o[vb][1]) + (o[vb][2] * o[vb][2] + o[vb][3] * o[vb][3]); }
    ss += __shfl_xor(ss, 16); ss += __shfl_xor(ss, 32);
    LAS float* SS = (LAS float*)C.lds;
    if (C.lane < 16) SS[w * 16 + C.lane] = ss;
    __syncthreads();
    const float rs = rsqrtf((SS[w * 16 + i] + SS[(w ^ 4) * 16 + i]) * (1.f / 128.f) + EPS);
#pragma unroll
    for (int vb = 0; vb < 4; ++vb) { const int v0 = 64 * vh + 16 * vb + kq * 4; const f32x4 gw = *(const f32x4*)(gnw + v0), zg = load4bf(Z + (size_t)(tok0 + t) * NIN + ZG + h * 128 + v0);
        store4bf(H + (size_t)(tok0 + t) * DM + h * 128 + v0, (f32x4){o[vb][0] * rs * gw[0] * silu2_f(zg[0]), o[vb][1] * rs * gw[1] * silu2_f(zg[1]), o[vb][2] * rs * gw[2] * silu2_f(zg[2]), o[vb][3] * rs * gw[3] * silu2_f(zg[3])}); }
    __syncthreads();
}
__device__ __forceinline__ void phase_m3(const Args& a, const Ctx& C) {
    for (int it = C.vcu; it < NBP * 4 * 32; it += C.G) hgrn_pass_c(a, C, it);
}

__global__ void __launch_bounds__(NTHR, 2) mk_fwd(Args args) {
    extern __shared__ __attribute__((aligned(16))) unsigned char lds_raw[];
    Ctx C;
    C.lds = (LAS unsigned char*)lds_raw;
    C.tid = threadIdx.x; C.lane = C.tid & 63; C.wave = __builtin_amdgcn_readfirstlane(C.tid >> 6);
    C.G = gridDim.x; { const int bx = blockIdx.x; C.vcu = (C.G % 8 == 0) ? (bx % 8) * (C.G / 8) + bx / 8 : bx; }
    volatile LAS unsigned* MISC = (volatile LAS unsigned*)(C.lds + MISC_OFF);
    for (int u = C.tid; u < (LDS_BYTES - LDSCTL_OFF) / 4; u += NTHR) ((LAS unsigned*)(C.lds + LDSCTL_OFF))[u] = 0u;
    __syncthreads();
    unsigned* barw = (unsigned*)(args.ws + WS_CTL) + CW_BAR;
    const int lo = args.ph_lo, hi = args.ph_hi;
    const bool multi = (hi - lo) > 1;
    XcdBarrier bar; bar.bar = barw; bar.x = 0; bar.st = nullptr;
    if (multi) bar = xcd_barrier_post(barw, MISC + 8);
    if (args.use_cg) cg::this_grid().sync();
#define IN(k) (lo <= (k) && (k) < hi)
#define SEAM(k) do { if (IN(k) && IN((k) + 1)) xcd_barrier(bar); } while (0)
    bf16* H = (bf16*)(args.ws + WS_H); bf16* Zb = (bf16*)(args.ws + WS_Z);
    if (IN(0)) { phase_p0(args, C); SEAM(0); }
    if (IN(1)) { phase_mod(args, C); SEAM(1); }
    if (IN(2)) { phase_p1(args, C); SEAM(2); }
    if (IN(3)) { pg8::Gemm g{H, (const bf16*)(args.ws + WS_WIN), MT, NIN, DM}; pg8::StaticOrder S; S.init(MT, NIN, C.G, (int)blockIdx.x);
        pg8::EpiStore E{Zb, NIN};
        pg8::gemm_phase<pg8::EpiStore, pg8::StaticOrder, true, true>(C.lds, g, S, E); SEAM(3); }
    if (IN(4)) { phase_m1(args, C); SEAM(4); }
    if (IN(5)) { phase_m2(args, C); SEAM(5); }
    if (IN(6)) { phase_m3(args, C); SEAM(6); }
    if (IN(7)) { pg8::Gemm g{H, (const bf16*)(args.ws + WS_WOUT), MT, DM, DM}; pg8::StaticOrder S; S.init(MT, DM, C.G, (int)blockIdx.x);
        pg8::EpiStore E{(bf16*)(args.ws + WS_MB), DM};
        pg8::gemm_phase<pg8::EpiStore, pg8::StaticOrder, true, true>(C.lds, g, S, E); SEAM(7); }
    if (IN(8)) { phase_p5(args, C); SEAM(8); }
    if (IN(9)) { pg8::Gemm g{H, (const bf16*)(args.ws + WS_WGU), MT, NGU, DM}; pg8::StaticOrder S; S.init(MT, NGU, C.G, (int)blockIdx.x);
        pg8::EpiSwiGLU E{(bf16*)(args.ws + WS_ACT), DFF};
        pg8::gemm_phase<pg8::EpiSwiGLU, pg8::StaticOrder, true, true>(C.lds, g, S, E); SEAM(9); }
    if (IN(10)) { pg8::Gemm g{(const bf16*)(args.ws + WS_ACT), (const bf16*)(args.ws + WS_WDN), MT, DM, DFF}; pg8::StaticOrder S; S.init(MT, DM, C.G, (int)blockIdx.x);
        pg8::EpiStore E{(bf16*)(args.ws + WS_FB), DM};
        pg8::gemm_phase<pg8::EpiStore, pg8::StaticOrder, true, true>(C.lds, g, S, E); SEAM(10); }
    if (IN(11)) { phase_p8(args, C); }
#undef IN
#undef SEAM
}

extern "C" void kernel_launch(void* const* d_in, const int* in_sizes, int n_in, void* d_out, int out_size, void* d_ws, size_t ws_size, hipStream_t stream) {
    static int grid = 0;
    if (grid == 0) {
        if (n_in != 22 || ws_size < WS_END) { fprintf(stderr, "kernel_launch: unexpected inputs (n_in %d, ws %zu)\n", n_in, ws_size); grid = -1; return; }
        int dev = 0, cus = 0, per_cu = 0;
        if (hipGetDevice(&dev) != hipSuccess || hipDeviceGetAttribute(&cus, hipDeviceAttributeMultiprocessorCount, dev) != hipSuccess) { grid = -1; return; }
        if (hipFuncSetAttribute((const void*)mk_fwd, hipFuncAttributeMaxDynamicSharedMemorySize, LDS_BYTES) != hipSuccess) { fprintf(stderr, "kernel_launch: hipFuncSetAttribute failed\n"); grid = -1; return; }
        if (hipOccupancyMaxActiveBlocksPerMultiprocessor(&per_cu, (const void*)mk_fwd, NTHR, LDS_BYTES) != hipSuccess || per_cu < 1) { fprintf(stderr, "kernel_launch: occupancy query says %d\n", per_cu); per_cu = 1; }
        (void)hipGetLastError();
        grid = cus;
    }
    if (grid < 0) return;
    (void)hipMemsetAsync((char*)d_ws + WS_CTL, 0, CTL_ZERO_BYTES, stream);
    Args a{};
    for (int i = 0; i < 22; ++i) a.in[i] = (const float*)d_in[i];
    a.out = (float*)d_out; a.ws = (unsigned char*)d_ws; a.use_cg = 0; a.pad = 0;
#if MK_N_LAUNCHES == 1
    a.ph_lo = 0; a.ph_hi = NPH;
    void* kargs[] = {&a};
    hipError_t e = hipLaunchCooperativeKernel((const void*)mk_fwd, dim3(grid), dim3(NTHR), kargs, LDS_BYTES, stream);
    if (e != hipSuccess) fprintf(stderr, "kernel_launch: cooperative launch failed: %s (grid %d)\n", hipGetErrorString(e), grid);
#else
    for (int p = 0; p < NPH; ++p) { a.ph_lo = p; a.ph_hi = p + 1; hipLaunchKernelGGL(mk_fwd, dim3(grid), dim3(NTHR), LDS_BYTES, stream, a); }
#endif
}
```

```cpp
#define MK_N_LAUNCHES 1
#include <hip/hip_runtime.h>
#include <hip/hip_cooperative_groups.h>
#include <cstdio>
#include <cstdint>
namespace pg8 {
#define PG8_LAS __attribute__((address_space(3)))
typedef unsigned short bf16_t;
typedef short bf16x8 __attribute__((ext_vector_type(8)));
typedef float f32x4 __attribute__((ext_vector_type(4)));
typedef unsigned u32x4 __attribute__((ext_vector_type(4)));
constexpr int BM = 256, BK = 64, HALF = 128, HTB = HALF * BK * 2  , STAGE_BYTES = 8 * HTB, NXCD = 8, WGM = 8;

__host__ __device__ __forceinline__ int lds_byte(int r, int c) { const int st = (r >> 4) * 2 + (c >> 5), rr = r & 15, cc = c & 31, ob = rr * 64 + cc * 2; return st * 1024 + (ob ^ (((ob >> 9) & 1) << 5)); }
__host__ __device__ __forceinline__ void stage_rc(int b, int& R, int& C) { const int st = b / 1024, sb = b % 1024, swz = sb ^ (((sb >> 9) & 1) << 5); R = (st >> 1) * 16 + swz / 64; C = (st & 1) * 32 + (swz % 64) / 2; }
__host__ __device__ __forceinline__ int perm32(int rho) { const int n = rho >> 4, i = rho & 15; return 8 * (i >> 2) + 4 * n + (i & 3); }

struct Unit { int pm, pn; };
struct Gemm { const bf16_t* A; const bf16_t* Bt; int M, N, K; };

struct StaticOrder {
    int nM, nN, nwg, G, c;
    __host__ __device__ void init(int M, int N, int G_, int c_) { nM = M / BM; nN = N / BM; nwg = nM * nN; G = G_; c = c_; }
    __host__ __device__ bool next(int i, Unit& u) const {
        const long L = (long)i * G + c; if (L >= nwg) return false;
        int wgid = (int)L; { const int q = nwg / NXCD, r = nwg % NXCD, xcd = wgid % NXCD, off = wgid / NXCD; wgid = (xcd < r ? xcd * (q + 1) : r * (q + 1) + (xcd - r) * q) + off; }
        const int nig = WGM * nN, gid = wgid / nig, fm = gid * WGM, gsz = (nM - fm) < WGM ? (nM - fm) : WGM;
        u.pm = fm + ((wgid % nig) % gsz); u.pn = (wgid % nig) / gsz; return true;
    }
    __device__ __forceinline__ void a_ready(const Unit&) const {}
    __device__ __forceinline__ void done(const Unit&) const {}
};
__device__ __forceinline__ unsigned cvt_pk_bf16(float lo, float hi) { unsigned r; asm volatile("v_cvt_pk_bf16_f32 %0, %1, %2" : "=v"(r) : "v"(lo), "v"(hi)); return r; }
struct EpiStore {
    static constexpr bool PERM = true, AFTER_DRAIN = false;
    bf16_t* O; int ldc;
    __device__ __forceinline__ void operator()(const f32x4 (&acc)[2][2][4][2], const Unit& u, int wr, int wc, int fr, int fq) const {
        const int row0 = u.pm * BM + wr * 64 + fr, col0 = u.pn * BM + wc * 32 + 8 * fq;
#pragma unroll
        for (int ai = 0; ai < 2; ++ai)
#pragma unroll
            for (int m = 0; m < 4; ++m) { bf16_t* rowp = O + (size_t)(row0 + ai * HALF + m * 16) * ldc + col0;
#pragma unroll
                for (int bj = 0; bj < 2; ++bj) { const f32x4 v0 = acc[ai][bj][m][0], v1 = acc[ai][bj][m][1];
                    u32x4 w; w.x = cvt_pk_bf16(v0[0], v0[1]); w.y = cvt_pk_bf16(v0[2], v0[3]); w.z = cvt_pk_bf16(v1[0], v1[1]); w.w = cvt_pk_bf16(v1[2], v1[3]);
                    *(u32x4*)(rowp + bj * HALF) = w; } }
    }
};
__device__ __forceinline__ float silu_f(float x) { return x * __builtin_amdgcn_rcpf(1.f + __expf(-x)); }
struct EpiSwiGLU {
    static constexpr bool PERM = true, AFTER_DRAIN = false;
    bf16_t* O; int ldc;
    __device__ __forceinline__ void operator()(const f32x4 (&acc)[2][2][4][2], const Unit& u, int wr, int wc, int fr, int fq) const {
        const int row0 = u.pm * BM + wr * 64 + fr, col0 = u.pn * HALF + wc * 32 + 8 * fq;
#pragma unroll
        for (int ai = 0; ai < 2; ++ai)
#pragma unroll
            for (int m = 0; m < 4; ++m) { bf16_t* rowp = O + (size_t)(row0 + ai * HALF + m * 16) * ldc + col0;
                const f32x4 g0 = acc[ai][0][m][0], g1 = acc[ai][0][m][1], u0 = acc[ai][1][m][0], u1 = acc[ai][1][m][1];
                u32x4 w;
                w.x = cvt_pk_bf16(silu_f(g0[0]) * u0[0], silu_f(g0[1]) * u0[1]); w.y = cvt_pk_bf16(silu_f(g0[2]) * u0[2], silu_f(g0[3]) * u0[3]);
                w.z = cvt_pk_bf16(silu_f(g1[0]) * u1[0], silu_f(g1[1]) * u1[1]); w.w = cvt_pk_bf16(silu_f(g1[2]) * u1[2], silu_f(g1[3]) * u1[3]);
                *(u32x4*)rowp = w; }
    }
};
template <class Epi, class Sched, bool ALIGN_EPI = false, bool SP2 = false>
__device__ __forceinline__ void gemm_phase(PG8_LAS unsigned char* lds, const Gemm g, const Sched& S, const Epi& E) {
    const int tid = threadIdx.x, wid = __builtin_amdgcn_readfirstlane(tid >> 6), lane = tid & 63, wr = wid >> 2, wc = wid & 3, fr = lane & 15, fq = lane >> 4;
    const int K = g.K, nt = K / BK;
    unsigned voffA[2], voffB[2];
#pragma unroll
    for (int i = 0; i < 2; ++i) { int R, C; stage_rc(tid * 16 + i * 8192, R, C); const int Rb = Epi::PERM ? ((R & ~31) + perm32(R & 31)) : R;
        voffA[i] = (unsigned)(R * K + C) * 2u; voffB[i] = (unsigned)(Rb * K + C) * 2u; }
    const size_t kstep = (size_t)(BK * 2);
    const size_t hstep = (size_t)HALF * K * 2;
    const size_t tstep = 2 * hstep;
    const unsigned ldsw = (unsigned)wid * 1024u;
    const int aoff = lds_byte(wr * 64 + fr, fq * 8), boff = lds_byte(wc * 32 + fr, fq * 8);
#define PG8_SA(b, h) (((b) * 2 + (h)) * HTB)
#define PG8_SB(b, h) ((4 + (b) * 2 + (h)) * HTB)
#define PG8_STAGE(bufoff, gbase, voff) do { _Pragma("unroll") for (int _i = 0; _i < 2; ++_i) \
        __builtin_amdgcn_global_load_lds((const unsigned*)((const char*)(gbase) + (voff)[_i]), (PG8_LAS unsigned*)(lds + (bufoff) + ldsw + _i * 8192), 16, 0, 0); } while (0)
#define PG8_LDA(dst, b, h) do { _Pragma("unroll") for (int m = 0; m < 4; ++m) _Pragma("unroll") for (int k = 0; k < 2; ++k) dst[m][k] = *(const PG8_LAS bf16x8*)(lds + PG8_SA(b, h) + aoff + m * 2048 + k * 1024); } while (0)
#define PG8_LDB(dst, b, h) do { _Pragma("unroll") for (int n = 0; n < 2; ++n) _Pragma("unroll") for (int k = 0; k < 2; ++k) dst[n][k] = *(const PG8_LAS bf16x8*)(lds + PG8_SB(b, h) + boff + n * 2048 + k * 1024); } while (0)
#define PG8_MMA(ai, bj, At, Bt) do { __builtin_amdgcn_s_setprio(1); _Pragma("unroll") for (int m = 0; m < 4; ++m) _Pragma("unroll") for (int n = 0; n < 2; ++n) _Pragma("unroll") for (int k = 0; k < 2; ++k) \
        acc[ai][bj][m][n] = __builtin_amdgcn_mfma_f32_16x16x32_bf16(Bt[n][k], At[m][k], acc[ai][bj][m][n], 0, 0, 0); __builtin_amdgcn_s_setprio(0); } while (0)
#define PG8_WAIT_V(n) asm volatile("s_waitcnt vmcnt(" #n ")" ::: "memory")
#define PG8_WAIT_L(n) asm volatile("s_waitcnt lgkmcnt(" #n ")" ::: "memory")
#define PG8_BAR __builtin_amdgcn_s_barrier()
#define PG8_SCHED __builtin_amdgcn_sched_barrier(0)
    Unit cur, nxt; int ui = 0;
    if (!S.next(0, cur)) return;
    f32x4 acc[2][2][4][2];
#pragma unroll
    for (int a = 0; a < 2; ++a)
#pragma unroll
        for (int b = 0; b < 2; ++b)
#pragma unroll
            for (int m = 0; m < 4; ++m)
#pragma unroll
                for (int n = 0; n < 2; ++n) acc[a][b][m][n] = (f32x4){0.f, 0.f, 0.f, 0.f};
    bf16x8 At[4][2], B0[2][2], B1[2][2];
    const char* cA = (const char*)g.A + (size_t)cur.pm * tstep; const char* cB = (const char*)g.Bt + (size_t)cur.pn * tstep;
    S.a_ready(cur);
    if constexpr (SP2) {
        PG8_STAGE(PG8_SB(0, 0), cB, voffB); PG8_STAGE(PG8_SB(0, 1), cB + hstep, voffB); PG8_STAGE(PG8_SA(0, 0), cA, voffA); PG8_STAGE(PG8_SA(0, 1), cA + hstep, voffA);
        if (wr == 1) PG8_BAR;
        PG8_WAIT_V(2); PG8_BAR;
        PG8_STAGE(PG8_SB(1, 0), cB + kstep, voffB); PG8_STAGE(PG8_SA(1, 0), cA + kstep, voffA); PG8_STAGE(PG8_SB(1, 1), cB + hstep + kstep, voffB);
        PG8_WAIT_V(6); PG8_BAR;
    } else {
        PG8_STAGE(PG8_SB(0, 0), cB, voffB); PG8_STAGE(PG8_SA(0, 0), cA, voffA); PG8_STAGE(PG8_SB(0, 1), cB + hstep, voffB); PG8_STAGE(PG8_SA(0, 1), cA + hstep, voffA);
        if (wr == 1) PG8_BAR;
        PG8_WAIT_V(4); PG8_BAR;
        PG8_STAGE(PG8_SB(1, 0), cB + kstep, voffB); PG8_STAGE(PG8_SA(1, 0), cA + kstep, voffA); PG8_STAGE(PG8_SB(1, 1), cB + hstep + kstep, voffB);
        PG8_WAIT_V(6); PG8_BAR;
    }
    for (;;) {
        const bool has_next = S.next(ui + 1, nxt);
        const char* nA = has_next ? (const char*)g.A + (size_t)nxt.pm * tstep : cA; const char* nB = has_next ? (const char*)g.Bt + (size_t)nxt.pn * tstep : cB;
        for (int t = 0; t < nt; t += 2) {
            const bool last = (t == nt - 2);
            const char* a1 = cA + (size_t)(t + 1) * kstep;
            const char* a2 = last ? nA : cA + (size_t)(t + 2) * kstep; const char* b2 = last ? nB : cB + (size_t)(t + 2) * kstep;
            const char* a3 = a2 + kstep; const char* b3 = b2 + kstep;
            if (last && has_next) S.a_ready(nxt);
            if constexpr (SP2) {
            PG8_LDB(B0, 0, 0); PG8_LDB(B1, 0, 1); PG8_SCHED; PG8_LDA(At, 0, 0); PG8_STAGE(PG8_SA(1, 1), a1 + hstep, voffA);
            PG8_WAIT_V(8); PG8_WAIT_L(0); PG8_BAR; PG8_MMA(0, 0, At, B0); PG8_MMA(0, 1, At, B1); PG8_BAR; PG8_SCHED;
            PG8_LDA(At, 0, 1); PG8_STAGE(PG8_SB(0, 0), b2, voffB); PG8_STAGE(PG8_SB(0, 1), b2 + hstep, voffB); PG8_STAGE(PG8_SA(0, 0), a2, voffA);
            PG8_WAIT_V(8); PG8_WAIT_L(0); PG8_BAR; PG8_MMA(1, 0, At, B0); PG8_MMA(1, 1, At, B1); PG8_BAR; PG8_SCHED;
            PG8_LDB(B0, 1, 0); PG8_LDB(B1, 1, 1); PG8_SCHED; PG8_LDA(At, 1, 0); PG8_STAGE(PG8_SA(0, 1), a2 + hstep, voffA);
            PG8_WAIT_V(8); PG8_WAIT_L(0); PG8_BAR; PG8_MMA(0, 0, At, B0); PG8_MMA(0, 1, At, B1); PG8_BAR; PG8_SCHED;
            PG8_LDA(At, 1, 1); PG8_STAGE(PG8_SB(1, 0), b3, voffB); PG8_STAGE(PG8_SB(1, 1), b3 + hstep, voffB); PG8_STAGE(PG8_SA(1, 0), a3, voffA);
            PG8_WAIT_V(8); PG8_WAIT_L(0); PG8_BAR; PG8_MMA(1, 0, At, B0); PG8_MMA(1, 1, At, B1); PG8_BAR; PG8_SCHED;
            } else {
            PG8_LDB(B0, 0, 0); PG8_SCHED; PG8_LDA(At, 0, 0); PG8_STAGE(PG8_SA(1, 1), a1 + hstep, voffA);
            PG8_WAIT_L(8); PG8_BAR; PG8_WAIT_L(0); PG8_MMA(0, 0, At, B0); PG8_BAR; PG8_SCHED;
            PG8_LDB(B1, 0, 1); PG8_STAGE(PG8_SB(0, 0), b2, voffB);
            PG8_BAR; PG8_WAIT_L(0); PG8_MMA(0, 1, At, B1); PG8_BAR;
            PG8_LDA(At, 0, 1); PG8_STAGE(PG8_SA(0, 0), a2, voffA);
            PG8_BAR; PG8_WAIT_L(0); PG8_MMA(1, 0, At, B0); PG8_BAR; PG8_SCHED;
            PG8_STAGE(PG8_SB(0, 1), b2 + hstep, voffB);
            PG8_WAIT_V(6); PG8_BAR; PG8_MMA(1, 1, At, B1); PG8_BAR;
            PG8_LDB(B0, 1, 0); PG8_SCHED; PG8_LDA(At, 1, 0); PG8_STAGE(PG8_SA(0, 1), a2 + hstep, voffA);
            PG8_WAIT_L(8); PG8_BAR; PG8_WAIT_L(0); PG8_MMA(0, 0, At, B0); PG8_BAR; PG8_SCHED;
            PG8_LDB(B1, 1, 1); PG8_STAGE(PG8_SB(1, 0), b3, voffB);
            PG8_BAR; PG8_WAIT_L(0); PG8_MMA(0, 1, At, B1); PG8_BAR;
            PG8_LDA(At, 1, 1); PG8_STAGE(PG8_SA(1, 0), a3, voffA);
            PG8_BAR; PG8_WAIT_L(0); PG8_MMA(1, 0, At, B0); PG8_BAR; PG8_SCHED;
            PG8_STAGE(PG8_SB(1, 1), b3 + hstep, voffB);
            PG8_WAIT_V(6); PG8_BAR; PG8_MMA(1, 1, At, B1); PG8_BAR;
            }
        }
        if constexpr (ALIGN_EPI) { if (wr == 0) PG8_BAR; }
        if constexpr (!Epi::AFTER_DRAIN) { E(acc, cur, wr, wc, fr, fq); S.done(cur); }
        if (!has_next) break;
#pragma unroll
        for (int a = 0; a < 2; ++a)
#pragma unroll
            for (int b = 0; b < 2; ++b)
#pragma unroll
                for (int m = 0; m < 4; ++m)
#pragma unroll
                    for (int n = 0; n < 2; ++n) acc[a][b][m][n] = (f32x4){0.f, 0.f, 0.f, 0.f};
        cur = nxt; cA = nA; cB = nB; ++ui;
        if constexpr (ALIGN_EPI) { if (wr == 1) PG8_BAR; }
    }
    PG8_WAIT_V(0);
    if constexpr (!ALIGN_EPI) { if (wr == 0) PG8_BAR; }
    PG8_BAR;
    if constexpr (Epi::AFTER_DRAIN) { E.fused(acc, cur, wr, wc, fr, fq, lds, wid, lane); S.done(cur); }
#undef PG8_SA
#undef PG8_SB
#undef PG8_STAGE
#undef PG8_LDA
#undef PG8_LDB
#undef PG8_MMA
#undef PG8_WAIT_V
#undef PG8_WAIT_L
#undef PG8_BAR
#undef PG8_SCHED
}
}

#define GAS __attribute__((address_space(1)))
#define LAS __attribute__((address_space(3)))
typedef unsigned short bf16;
typedef unsigned v4u __attribute__((ext_vector_type(4)));
typedef unsigned v2u __attribute__((ext_vector_type(2)));
typedef float f32x4 __attribute__((ext_vector_type(4)));
typedef short bf16x8 __attribute__((ext_vector_type(8)));
typedef GAS unsigned gu32;
#define RLX_AGENT __ATOMIC_RELAXED, __HIP_MEMORY_SCOPE_AGENT
#define LDS_WAIT() asm volatile("s_waitcnt lgkmcnt(0)" ::: "memory")
#define VM_WAIT() asm volatile("s_waitcnt vmcnt(0)" ::: "memory")
__device__ __forceinline__ unsigned f2bf(float f) { unsigned u = __builtin_bit_cast(unsigned, f); return (u + 0x7fffu + ((u >> 16) & 1u)) >> 16; }
__device__ __forceinline__ unsigned pk2(float lo, float hi) { return f2bf(lo) | (f2bf(hi) << 16); }
#define XB_TMO      128
#define XB_XCNT(j)  (256  + 64 * (j))
#define XB_XSUB(j)  (1280 + 64 * (j))
#define XB_XGEN(j)  (2304 + 64 * (j))
#define XB_TOP      3328
#define XB_TOPGEN   3392
#define XCD_BAR_WORDS 3456
#define XB_SPIN_CAP (1u << 18)

__device__ __forceinline__ unsigned xb_ld(unsigned* p)              { return __hip_atomic_load(p, __ATOMIC_RELAXED, __HIP_MEMORY_SCOPE_AGENT); }
__device__ __forceinline__ unsigned xb_add(unsigned* p, unsigned v) { return __hip_atomic_fetch_add(p, v, __ATOMIC_RELAXED, __HIP_MEMORY_SCOPE_AGENT); }
__device__ __forceinline__ unsigned xb_xcc_id() { return (unsigned)__builtin_amdgcn_s_getreg((3 << 11) | 20) & 0xFu; }
#define XB_SPIN(cond, bar) do { unsigned _sp = 0; while (cond) { __builtin_amdgcn_s_sleep(1); \
    if ((++_sp & 255u) == 0u) { if (xb_ld(&(bar)[XB_TMO])) break; if (_sp > XB_SPIN_CAP) { atomicAdd(&(bar)[XB_TMO], 1u); break; } } } } while (0)

struct XcdBarrier {
    unsigned* bar; unsigned x;
    volatile LAS unsigned* st;
};

__device__ __forceinline__ XcdBarrier xcd_barrier_post(unsigned* bar, volatile LAS unsigned* st) {
    XcdBarrier b; b.bar = bar; b.x = xb_xcc_id(); b.st = st;
    if (threadIdx.x == 0) (void)xb_add(&bar[XB_XCNT(b.x)], 1u);
    return b;
}
__device__ __forceinline__ void xcd_barrier_complete(unsigned* bar, unsigned x, unsigned& nloc, unsigned& nx) {
    const unsigned G = gridDim.x * gridDim.y * gridDim.z;
    unsigned sum, cnt, mine, sp = 0u;
    for (;;) {
        sum = 0u; cnt = 0u; mine = 0u;
#pragma unroll
        for (unsigned j = 0; j < 16; ++j) { const unsigned c = xb_ld(&bar[XB_XCNT(j)]); sum += c; cnt += (c > 0u) ? 1u : 0u; mine = (j == x) ? c : mine; }
        if (sum == G) break;
        __builtin_amdgcn_s_sleep(1);
        if ((++sp & 255u) == 0u) { if (xb_ld(&bar[XB_TMO])) break; if (sp > XB_SPIN_CAP) { atomicAdd(&bar[XB_TMO], 1u); break; } }
    }
    nloc = mine > 0u ? mine : 1u; nx = cnt > 0u ? cnt : 1u;
}

__device__ __forceinline__ void xcd_barrier(const XcdBarrier& b) {
    asm volatile("s_waitcnt vmcnt(0)" ::: "memory");
    __syncthreads();
    if (threadIdx.x == 0) {
        unsigned* bar = b.bar;
        __builtin_amdgcn_s_waitcnt(0);
        unsigned nloc = b.st[0], nx = b.st[1];
        if (nloc == 0u) { xcd_barrier_complete(bar, b.x, nloc, nx); b.st[0] = nloc; b.st[1] = nx; }
        const unsigned old = xb_add(&bar[XB_XSUB(b.x)], 1u);
        const unsigned gen = old / nloc;
        if (old + 1u == (gen + 1u) * nloc) {
            __builtin_amdgcn_fence(__ATOMIC_RELEASE, "agent");
            asm volatile("s_waitcnt vmcnt(0)" ::: "memory");
            const unsigned og = xb_add(&bar[XB_TOP], 1u);
            const unsigned tg = og / nx;
            if (og + 1u == (tg + 1u) * nx) xb_add(&bar[XB_TOPGEN], 1u);
            else XB_SPIN(xb_ld(&bar[XB_TOPGEN]) == tg, bar);
            __builtin_amdgcn_fence(__ATOMIC_ACQUIRE, "agent");
            xb_add(&bar[XB_XGEN(b.x)], 1u);
            asm volatile("s_waitcnt vmcnt(0)" ::: "memory");
        } else {
            XB_SPIN(xb_ld(&bar[XB_XGEN(b.x)]) == gen, bar);
            __builtin_amdgcn_fence(__ATOMIC_ACQUIRE, "agent");
            asm volatile("s_waitcnt vmcnt(0)" ::: "memory");
        }
    }
    __syncthreads();
}

namespace cg = cooperative_groups;
constexpr int NWAVES = 8, NTHR = 512;
constexpr int DM = 1024, NBP = 8, SEQ = 2048, NBS = 128, DSEQ = 8, MP = NBP * SEQ, MS = NBS * DSEQ, MT = MP + MS, NSEQ = NBP + NBS;
constexpr int NIN = 3072, DFF = 2816, NGU = 2 * DFF, NMOD = 6 * DM;
constexpr int ZQ = 0, ZF = 512, ZI = 1024, ZG = 1536, ZU = 2048, ZV = 2560;
constexpr float EPS = 1e-6f;
constexpr size_t O_Y = 0, O_SP = (size_t)MT * DM, O_SS = O_SP + (size_t)NBP * 4 * 16384, O_VP = O_SS + (size_t)NBS * 4 * 16384, O_VS = O_VP + (size_t)NBP * 128 * 512;
constexpr size_t MiB = 1u << 20;
constexpr size_t OUT_QD = 0, OUT_OI = 16 * MiB;
constexpr size_t WS_CTL = 0, CTL_ZERO_BYTES = 64 * 1024;
constexpr size_t WS_WIN = 1 * MiB, WS_WOUT = 7 * MiB, WS_WGU = 9 * MiB, WS_WDN = 20 * MiB, WS_MOD = 26 * MiB, WS_SC = 30 * MiB, WS_DEC = 31 * MiB;
constexpr size_t WS_H = 32 * MiB, WS_Z = 66 * MiB, WS_DS = 168 * MiB, WS_END = 232 * MiB;
constexpr size_t WS_ACT = WS_Z, WS_MB = WS_DS, WS_FB = WS_DS;
static_assert(WS_WDN + (size_t)DM * DFF * 2 <= WS_MOD && WS_MOD + (size_t)NSEQ * NMOD * 4 <= WS_SC && WS_H + (size_t)MT * DM * 2 <= WS_Z && WS_Z + (size_t)MT * NIN * 2 <= WS_DS, "ws map");
static_assert(WS_ACT + (size_t)MT * DFF * 2 <= WS_DS && WS_DS + (size_t)1024 * 16384 * 4 <= WS_END, "ws map 2");
constexpr int CW_BAR = 4096;
constexpr int RING_BYTES = 131072, LDSCTL_OFF = RING_BYTES, MISC_OFF = LDSCTL_OFF + 320, LDS_BYTES = 147456;
constexpr int NPH = 12;
#ifndef MK_N_LAUNCHES
#define MK_N_LAUNCHES 1
#endif

__device__ __forceinline__ float wave_sum(float v) {
#pragma unroll
    for (int o = 1; o < 64; o <<= 1) v += __shfl_xor(v, o);
    return v;
}
__device__ __forceinline__ float bflo(unsigned u) { return __uint_as_float(u << 16); }
__device__ __forceinline__ float bfhi(unsigned u) { return __uint_as_float(u & 0xffff0000u); }
__device__ __forceinline__ float rcp_f(float x) { return __builtin_amdgcn_rcpf(x); }
__device__ __forceinline__ float sigm_f(float x) { return rcp_f(1.f + __expf(-x)); }
__device__ __forceinline__ float silu2_f(float x) { return x * sigm_f(x); }
__device__ __forceinline__ float gelu_f(float x) { return x * sigm_f(1.5957691216057308f * (x + 0.044715f * x * x * x)); }
__device__ __forceinline__ bf16x8 pack8(f32x4 a, f32x4 b) { v4u t; t.x = pg8::cvt_pk_bf16(a[0], a[1]); t.y = pg8::cvt_pk_bf16(a[2], a[3]); t.z = pg8::cvt_pk_bf16(b[0], b[1]); t.w = pg8::cvt_pk_bf16(b[2], b[3]); return __builtin_bit_cast(bf16x8, t); }
#define MFMA16(a, b, c) __builtin_amdgcn_mfma_f32_16x16x32_bf16((a), (b), (c), 0, 0, 0)

struct Args { const float* in[22]; float* out; unsigned char* ws; int ph_lo, ph_hi, use_cg, pad; };
struct Ctx { LAS unsigned char* lds; int tid, lane, wave, vcu, G; };

__device__ __forceinline__ void transpose_item(const float* W, int K, int N, bf16* WT, int kb, int n0, int drow0, LAS float* scr, int lane) {
    const int k0 = 64 * kb;
#pragma unroll 8
    for (int i = 0; i < 32; ++i) { const int kk = 2 * i + (lane >> 5); scr[kk * 33 + (lane & 31)] = W[(size_t)(k0 + kk) * N + n0 + (lane & 31)]; }
    LDS_WAIT(); asm volatile("" ::: "memory");
    const int c = lane & 7;
#pragma unroll
    for (int j = 0; j < 4; ++j) { const int n = (lane >> 3) + 8 * j; const LAS float* s = scr + (8 * c) * 33 + n;
        v4u o; o.x = pk2(s[0 * 33], s[1 * 33]); o.y = pk2(s[2 * 33], s[3 * 33]); o.z = pk2(s[4 * 33], s[5 * 33]); o.w = pk2(s[6 * 33], s[7 * 33]);
        *(v4u*)(WT + (size_t)(drow0 + n) * K + k0 + 8 * c) = o; }
    LDS_WAIT(); asm volatile("" ::: "memory");
}
__device__ __forceinline__ void phase_p0(const Args& a, const Ctx& C) {
    unsigned char* ws = a.ws;
    { bf16* SC = (bf16*)(ws + WS_SC); const float* cp = a.in[3]; const float* cs = a.in[4];
      for (int e = C.vcu * NTHR + C.tid; e < 144 * DM; e += C.G * NTHR) { const int r = e >> 10; float v = 0.f;
          if (r < NBP) v = silu2_f(cp[e]); else if (r < NSEQ) v = silu2_f(cs[e - NBP * DM]);
          SC[e] = (bf16)f2bf(v); } }
    LAS float* scr = (LAS float*)(C.lds + C.wave * 16384);
    const int gw = C.vcu * NWAVES + C.wave, NGW = C.G * NWAVES;
    constexpr int I_IN = 16 * 96, I_OUT = 16 * 32, I_G = 16 * 88, I_D = 44 * 32, NITEMS = I_IN + I_OUT + 2 * I_G + I_D;
    for (int it = gw; it < NITEMS; it += NGW) {
        int r = it;
        if (r < I_IN) { const int kb = r / 96, n0 = 32 * (r % 96); transpose_item(a.in[10], DM, NIN, (bf16*)(ws + WS_WIN), kb, n0, n0, scr, C.lane); continue; } r -= I_IN;
        if (r < I_OUT) { const int kb = r / 32, n0 = 32 * (r % 32); transpose_item(a.in[16], DM, DM, (bf16*)(ws + WS_WOUT), kb, n0, n0, scr, C.lane); continue; } r -= I_OUT;
        if (r < I_G) { const int kb = r / 88, n0 = 32 * (r % 88); transpose_item(a.in[19], DM, DFF, (bf16*)(ws + WS_WGU), kb, n0, 256 * (n0 >> 7) + (n0 & 127), scr, C.lane); continue; } r -= I_G;
        if (r < I_G) { const int kb = r / 88, n0 = 32 * (r % 88); transpose_item(a.in[20], DM, DFF, (bf16*)(ws + WS_WGU), kb, n0, 256 * (n0 >> 7) + 128 + (n0 & 127), scr, C.lane); continue; } r -= I_G;
        { const int kb = r / 32, n0 = 32 * (r % 32); transpose_item(a.in[21], DFF, DM, (bf16*)(ws + WS_WDN), kb, n0, n0, scr, C.lane); }
    }
}
__device__ __forceinline__ void phase_mod(const Args& a, const Ctx& C) {
    const bf16* SC = (const bf16*)(a.ws + WS_SC); const float* wada = a.in[6]; const float* bada = a.in[7]; float* MOD = (float*)(a.ws + WS_MOD);
    const int i = C.lane & 15, kq = C.lane >> 4;
    for (int it = C.wave * C.G + C.vcu; it < NMOD / 16; it += C.G * NWAVES) {
        const int n0 = it * 16;
        f32x4 acc[9];
#pragma unroll
        for (int rb = 0; rb < 9; ++rb) acc[rb] = (f32x4){0.f, 0.f, 0.f, 0.f};
#pragma unroll 2
        for (int ks = 0; ks < 32; ++ks) {
            const int k0 = ks * 32 + kq * 8;
            const float* wp = wada + (size_t)k0 * NMOD + n0 + i;
            f32x4 w0, w1;
            w0[0] = wp[0]; w0[1] = wp[(size_t)NMOD]; w0[2] = wp[(size_t)2 * NMOD]; w0[3] = wp[(size_t)3 * NMOD];
            w1[0] = wp[(size_t)4 * NMOD]; w1[1] = wp[(size_t)5 * NMOD]; w1[2] = wp[(size_t)6 * NMOD]; w1[3] = wp[(size_t)7 * NMOD];
            const bf16x8 af = pack8(w0, w1);
#pragma unroll
            for (int rb = 0; rb < 9; ++rb) { const bf16x8 bfr = *(const bf16x8*)(SC + (size_t)(rb * 16 + i) * DM + k0); acc[rb] = MFMA16(af, bfr, acc[rb]); }
        }
        const int n = n0 + kq * 4; const f32x4 bias = *(const f32x4*)(bada + n);
#pragma unroll
        for (int rb = 0; rb < 9; ++rb) { const int r = rb * 16 + i; if (r < NSEQ) *(f32x4*)(MOD + (size_t)r * NMOD + n) = acc[rb] + bias; }
    }
}
__device__ __forceinline__ const float* xrow_ptr(const Args& a, int m) { return m < MP ? a.in[0] + (size_t)m * DM : a.in[1] + (size_t)(m - MP) * DM; }
__device__ __forceinline__ int seq_of(int m) { return m < MP ? (m >> 11) : NBP + ((m - MP) >> 3); }
__device__ __forceinline__ void store4bf(bf16* p, f32x4 v) { v2u o; o.x = pg8::cvt_pk_bf16(v[0], v[1]); o.y = pg8::cvt_pk_bf16(v[2], v[3]); *(v2u*)p = o; }
__device__ __forceinline__ f32x4 load4bf(const bf16* p) { const v2u w = *(const v2u*)p; return (f32x4){bflo(w.x), bfhi(w.x), bflo(w.y), bfhi(w.y)}; }
__device__ __forceinline__ void phase_p1(const Args& a, const Ctx& C) {
    const float* MOD = (const float*)(a.ws + WS_MOD); bf16* H = (bf16*)(a.ws + WS_H); const float* npm = a.in[8];
    for (int m = C.vcu * NWAVES + C.wave; m < MT; m += C.G * NWAVES) {
        const float* xr = xrow_ptr(a, m); const float* md = MOD + (size_t)seq_of(m) * NMOD;
        f32x4 v[4]; float ss = 0.f;
#pragma unroll
        for (int j = 0; j < 4; ++j) { v[j] = *(const f32x4*)(xr + 4 * C.lane + 256 * j); ss += (v[j][0] * v[j][0] + v[j][1] * v[j][1]) + (v[j][2] * v[j][2] + v[j][3] * v[j][3]); }
        const float rs = rsqrtf(wave_sum(ss) * (1.f / DM) + EPS);
#pragma unroll
        for (int j = 0; j < 4; ++j) { const int c = 4 * C.lane + 256 * j;
            const f32x4 g = *(const f32x4*)(npm + c), sh = *(const f32x4*)(md + c), sc = *(const f32x4*)(md + DM + c);
            store4bf(H + (size_t)m * DM + c, v[j] * rs * g * (sc + 1.f) + sh); }
    }
}
__device__ __forceinline__ void phase_p5(const Args& a, const Ctx& C) {
    const float* MOD = (const float*)(a.ws + WS_MOD); bf16* H = (bf16*)(a.ws + WS_H); const bf16* MB = (const bf16*)(a.ws + WS_MB);
    const float* npost = a.in[9]; const float* npre = a.in[17];
    for (int m = C.vcu * NWAVES + C.wave; m < MT; m += C.G * NWAVES) {
        const float* xr = xrow_ptr(a, m); const float* md = MOD + (size_t)seq_of(m) * NMOD;
        f32x4 mv[4]; float ss = 0.f;
#pragma unroll
        for (int j = 0; j < 4; ++j) { mv[j] = load4bf(MB + (size_t)m * DM + 4 * C.lane + 256 * j); ss += (mv[j][0] * mv[j][0] + mv[j][1] * mv[j][1]) + (mv[j][2] * mv[j][2] + mv[j][3] * mv[j][3]); }
        const float rs = rsqrtf(wave_sum(ss) * (1.f / DM) + EPS);
        f32x4 x1[4]; float ss2 = 0.f;
#pragma unroll
        for (int j = 0; j < 4; ++j) { const int c = 4 * C.lane + 256 * j;
            const f32x4 xv = *(const f32x4*)(xr + c), g = *(const f32x4*)(npost + c), g1 = *(const f32x4*)(md + 2 * DM + c);
            x1[j] = xv + g1 * (mv[j] * rs * g);
            *(f32x4*)(a.out + O_Y + (size_t)m * DM + c) = x1[j];
            ss2 += (x1[j][0] * x1[j][0] + x1[j][1] * x1[j][1]) + (x1[j][2] * x1[j][2] + x1[j][3] * x1[j][3]); }
        const float rs2 = rsqrtf(wave_sum(ss2) * (1.f / DM) + EPS);
#pragma unroll
        for (int j = 0; j < 4; ++j) { const int c = 4 * C.lane + 256 * j;
            const f32x4 g = *(const f32x4*)(npre + c), sh = *(const f32x4*)(md + 3 * DM + c), sc = *(const f32x4*)(md + 4 * DM + c);
            store4bf(H + (size_t)m * DM + c, x1[j] * rs2 * g * (sc + 1.f) + sh); }
    }
}
__device__ __forceinline__ void phase_p8(const Args& a, const Ctx& C) {
    const float* MOD = (const float*)(a.ws + WS_MOD); const bf16* FB = (const bf16*)(a.ws + WS_FB); const float* npf = a.in[18];
    for (int m = C.vcu * NWAVES + C.wave; m < MT; m += C.G * NWAVES) {
        const float* md = MOD + (size_t)seq_of(m) * NMOD;
        f32x4 fv[4]; float ss = 0.f;
#pragma unroll
        for (int j = 0; j < 4; ++j) { fv[j] = load4bf(FB + (size_t)m * DM + 4 * C.lane + 256 * j); ss += (fv[j][0] * fv[j][0] + fv[j][1] * fv[j][1]) + (fv[j][2] * fv[j][2] + fv[j][3] * fv[j][3]); }
        const float rs = rsqrtf(wave_sum(ss) * (1.f / DM) + EPS);
#pragma unroll
        for (int j = 0; j < 4; ++j) { const int c = 4 * C.lane + 256 * j; float* op = a.out + O_Y + (size_t)m * DM + c;
            const f32x4 x1 = *(const f32x4*)op, g = *(const f32x4*)(npf + c), g2 = *(const f32x4*)(md + 5 * DM + c);
            *(f32x4*)op = x1 + g2 * (fv[j] * rs * g); }
    }
}
constexpr int A_LF = 0, A_LFS = 132, A_PT = 33792, A_QD = 35840, A_KD = 53248, A_KET = 70656, A_VT = 89088, A_PP = 107520, A_LB = 116736;
__device__ __forceinline__ void unpack16(const v4u a, const v4u b, float (&z)[16]) {
    z[0] = bflo(a.x); z[1] = bfhi(a.x); z[2] = bflo(a.y); z[3] = bfhi(a.y); z[4] = bflo(a.z); z[5] = bfhi(a.z); z[6] = bflo(a.w); z[7] = bfhi(a.w);
    z[8] = bflo(b.x); z[9] = bfhi(b.x); z[10] = bflo(b.y); z[11] = bfhi(b.y); z[12] = bflo(b.z); z[13] = bfhi(b.z); z[14] = bflo(b.w); z[15] = bfhi(b.w);
}
__device__ __forceinline__ void hgrn_pass_a(const Args& a, const Ctx& C, int item) {
    const bf16* Z = (const bf16*)(a.ws + WS_Z); float* DS = (float*)(a.ws + WS_DS); float* DEC = (float*)(a.ws + WS_DEC);
    bf16* QDG = (bf16*)((unsigned char*)a.out + OUT_QD); float* OI = (float*)((unsigned char*)a.out + OUT_OI);
    const float* lbl = a.in[5];
    const int bh = item >> 5, n = item & 31, b = bh >> 2, h = bh & 3, tok0 = b * SEQ + n * 64;
    LAS unsigned char* lds = C.lds; LAS float* LF = (LAS float*)(lds + A_LF); LAS float* PT = (LAS float*)(lds + A_PT); LAS float* LB = (LAS float*)(lds + A_LB);
    const int tid = C.tid, w = C.wave, i = C.lane & 15, kq = C.lane >> 4;
    if (tid < 128) { const float l0 = lbl[h * 128 + tid], l1 = lbl[512 + h * 128 + tid]; LB[tid] = rcp_f(1.f + __expf(l1 - l0)); }
    __syncthreads();
    const int t = tid >> 3, c0 = (tid & 7) * 16;
    const bf16* zrow = Z + (size_t)(tok0 + t) * NIN + h * 128 + c0;
    float kk[16];
    { const v4u f0 = *(const v4u*)(zrow + ZF), f1 = *(const v4u*)(zrow + ZF + 8); float z[16]; unpack16(f0, f1, z);
#pragma unroll
      for (int j = 0; j < 16; ++j) { const float lb = LB[c0 + j], sg = sigm_f(z[j]); const float f = lb + (1.f - lb) * sg; kk[j] = (1.f - lb) * (1.f - sg); LF[t * A_LFS + c0 + j] = __logf(f); } }
    __syncthreads();
    { const int k = tid & 127, part = tid >> 7; float run = 0.f;
#pragma unroll
      for (int r = 0; r < 16; ++r) { LAS float* p = LF + (part * 16 + r) * A_LFS + k; run += *p; *p = run; }
      PT[part * 128 + k] = run; }
    __syncthreads();
    { const int k = tid & 127, part = tid >> 7;
      const float off = (part > 0 ? PT[k] : 0.f) + (part > 1 ? PT[128 + k] : 0.f) + (part > 2 ? PT[256 + k] : 0.f);
      if (part > 0) {
#pragma unroll
          for (int r = 0; r < 16; ++r) LF[(part * 16 + r) * A_LFS + k] += off; } }
    __syncthreads();
    { const v4u q0 = *(const v4u*)(zrow + ZQ), q1 = *(const v4u*)(zrow + ZQ + 8), i0 = *(const v4u*)(zrow + ZI), i1 = *(const v4u*)(zrow + ZI + 8);
      float q[16]; unpack16(q0, q1, q);
      float qd[16], kd[16], ke[16];
#pragma unroll
      for (int j = 0; j < 16; ++j) { const float bb = LF[t * A_LFS + c0 + j], bl = LF[63 * A_LFS + c0 + j];
          qd[j] = q[j] * __expf(bb); kd[j] = kk[j] * __expf(-bb); ke[j] = kk[j] * __expf(bl - bb);
          if (t == 63) DEC[(size_t)item * 128 + c0 + j] = __expf(bl); }
      v4u o0, o1;
      o0.x = pg8::cvt_pk_bf16(qd[0], qd[1]); o0.y = pg8::cvt_pk_bf16(qd[2], qd[3]); o0.z = pg8::cvt_pk_bf16(qd[4], qd[5]); o0.w = pg8::cvt_pk_bf16(qd[6], qd[7]);
      o1.x = pg8::cvt_pk_bf16(qd[8], qd[9]); o1.y = pg8::cvt_pk_bf16(qd[10], qd[11]); o1.z = pg8::cvt_pk_bf16(qd[12], qd[13]); o1.w = pg8::cvt_pk_bf16(qd[14], qd[15]);
      *(LAS v4u*)(lds + A_QD + t * 272 + c0 * 2) = o0; *(LAS v4u*)(lds + A_QD + t * 272 + c0 * 2 + 16) = o1;
      bf16* qg = QDG + (size_t)(tok0 + t) * 512 + h * 128 + c0; *(v4u*)qg = o0; *(v4u*)(qg + 8) = o1;
      o0.x = pg8::cvt_pk_bf16(kd[0], kd[1]); o0.y = pg8::cvt_pk_bf16(kd[2], kd[3]); o0.z = pg8::cvt_pk_bf16(kd[4], kd[5]); o0.w = pg8::cvt_pk_bf16(kd[6], kd[7]);
      o1.x = pg8::cvt_pk_bf16(kd[8], kd[9]); o1.y = pg8::cvt_pk_bf16(kd[10], kd[11]); o1.z = pg8::cvt_pk_bf16(kd[12], kd[13]); o1.w = pg8::cvt_pk_bf16(kd[14], kd[15]);
      *(LAS v4u*)(lds + A_KD + t * 272 + c0 * 2) = o0; *(LAS v4u*)(lds + A_KD + t * 272 + c0 * 2 + 16) = o1;
      const unsigned vi[8] = {i0.x, i0.y, i0.z, i0.w, i1.x, i1.y, i1.z, i1.w};
#pragma unroll
      for (int j = 0; j < 16; ++j) {
          *(LAS unsigned short*)(lds + A_KET + (c0 + j) * 144 + t * 2) = (unsigned short)f2bf(ke[j]);
          *(LAS unsigned short*)(lds + A_VT + (c0 + j) * 144 + t * 2) = (unsigned short)((j & 1) ? (vi[j >> 1] >> 16) : (vi[j >> 1] & 0xffffu)); } }
    __syncthreads();
    { const int tb = w >> 1;
#pragma unroll
      for (int e = 0; e < 2; ++e) { const int sb = 2 * (w & 1) + e; f32x4 acc = (f32x4){0.f, 0.f, 0.f, 0.f};
#pragma unroll
          for (int ks = 0; ks < 4; ++ks) { const bf16x8 A = *(const LAS bf16x8*)(lds + A_KD + (16 * sb + i) * 272 + (ks * 32 + kq * 8) * 2), B = *(const LAS bf16x8*)(lds + A_QD + (16 * tb + i) * 272 + (ks * 32 + kq * 8) * 2);
              acc = MFMA16(A, B, acc); }
          const int tt = 16 * tb + i, s0 = 16 * sb + kq * 4;
          v2u o; o.x = pg8::cvt_pk_bf16(s0 <= tt ? acc[0] : 0.f, s0 + 1 <= tt ? acc[1] : 0.f); o.y = pg8::cvt_pk_bf16(s0 + 2 <= tt ? acc[2] : 0.f, s0 + 3 <= tt ? acc[3] : 0.f);
          *(LAS v2u*)(lds + A_PP + tt * 144 + s0 * 2) = o; } }
    { bf16x8 A2[2];
#pragma unroll
      for (int sc = 0; sc < 2; ++sc) A2[sc] = *(const LAS bf16x8*)(lds + A_KET + (16 * w + i) * 144 + (sc * 32 + kq * 8) * 2);
#pragma unroll
      for (int vb = 0; vb < 8; ++vb) { f32x4 acc = (f32x4){0.f, 0.f, 0.f, 0.f};
#pragma unroll
          for (int sc = 0; sc < 2; ++sc) { const bf16x8 B = *(const LAS bf16x8*)(lds + A_VT + (16 * vb + i) * 144 + (sc * 32 + kq * 8) * 2); acc = MFMA16(A2[sc], B, acc); }
          *(f32x4*)(DS + (size_t)item * 16384 + (16 * vb + i) * 128 + 16 * w + kq * 4) = acc; } }
    __syncthreads();
    { bf16x8 A3[2];
#pragma unroll
      for (int sc = 0; sc < 2; ++sc) A3[sc] = *(const LAS bf16x8*)(lds + A_VT + (16 * w + i) * 144 + (sc * 32 + kq * 8) * 2);
#pragma unroll
      for (int tb = 0; tb < 4; ++tb) { f32x4 acc = (f32x4){0.f, 0.f, 0.f, 0.f};
#pragma unroll
          for (int sc = 0; sc < 2; ++sc) { const bf16x8 B = *(const LAS bf16x8*)(lds + A_PP + (16 * tb + i) * 144 + (sc * 32 + kq * 8) * 2); acc = MFMA16(A3[sc], B, acc); }
          *(f32x4*)(OI + (size_t)(tok0 + 16 * tb + i) * 512 + h * 128 + 16 * w + kq * 4) = acc; } }
    __syncthreads();
}
__device__ __forceinline__ void hgrn_sample(const Args& a, const Ctx& C, int item) {
    const bf16* Z = (const bf16*)(a.ws + WS_Z); bf16* H = (bf16*)(a.ws + WS_H); const float* lbl = a.in[5]; const float* gnw = a.in[11];
    const int b = item >> 2, h = item & 3, m0 = MP + b * DSEQ, tid = C.tid;
    LAS float* F8 = (LAS float*)C.lds; LAS float* K8 = F8 + 1024; LAS float* Q8 = F8 + 2048; LAS float* V8 = F8 + 3072; LAS float* OP = F8 + 4096;
    for (int idx = tid; idx < 1024; idx += NTHR) { const int t = idx >> 7, k = idx & 127; const bf16* zr = Z + (size_t)(m0 + t) * NIN + h * 128 + k;
        const float l0 = lbl[h * 128 + k], l1 = lbl[512 + h * 128 + k], lb = rcp_f(1.f + __expf(l1 - l0));
        const float sg = sigm_f(bflo(zr[ZF])); F8[idx] = lb + (1.f - lb) * sg; K8[idx] = (1.f - lb) * (1.f - sg); Q8[idx] = bflo(zr[ZQ]); V8[idx] = bflo(zr[ZI]); }
    __syncthreads();
    const int v = tid & 127, kp = tid >> 7;
    const size_t sbase = ((size_t)item * 128 + kp * 32) * 128 + v;
    const float* s0 = a.in[2] + sbase;
    float S[32];
#pragma unroll
    for (int r = 0; r < 32; ++r) S[r] = s0[(size_t)r * 128];
#pragma unroll 1
    for (int t = 0; t < DSEQ; ++t) { const float vt = V8[t * 128 + v]; float o = 0.f;
#pragma unroll
        for (int r4 = 0; r4 < 8; ++r4) { const f32x4 f = *(const LAS f32x4*)(F8 + t * 128 + kp * 32 + r4 * 4), kx = *(const LAS f32x4*)(K8 + t * 128 + kp * 32 + r4 * 4), qx = *(const LAS f32x4*)(Q8 + t * 128 + kp * 32 + r4 * 4);
#pragma unroll
            for (int e = 0; e < 4; ++e) { S[r4 * 4 + e] = f[e] * S[r4 * 4 + e] + kx[e] * vt; o += S[r4 * 4 + e] * qx[e]; } }
        OP[(t * 4 + kp) * 128 + v] = o; }
    float* so = a.out + O_SS + sbase;
#pragma unroll
    for (int r = 0; r < 32; ++r) so[(size_t)r * 128] = S[r];
    __syncthreads();
    { const int t = C.wave, l = C.lane;
      const float o0 = (OP[(t * 4 + 0) * 128 + l] + OP[(t * 4 + 1) * 128 + l]) + (OP[(t * 4 + 2) * 128 + l] + OP[(t * 4 + 3) * 128 + l]);
      const float o1 = (OP[(t * 4 + 0) * 128 + 64 + l] + OP[(t * 4 + 1) * 128 + 64 + l]) + (OP[(t * 4 + 2) * 128 + 64 + l] + OP[(t * 4 + 3) * 128 + 64 + l]);
      const float rs = rsqrtf(wave_sum(o0 * o0 + o1 * o1) * (1.f / 128.f) + EPS);
      const bf16* zg = Z + (size_t)(m0 + t) * NIN + ZG + h * 128; bf16* hp = H + (size_t)(m0 + t) * DM + h * 128;
      hp[l] = (bf16)f2bf(o0 * rs * gnw[l] * silu2_f(bflo(zg[l]))); hp[64 + l] = (bf16)f2bf(o1 * rs * gnw[64 + l] * silu2_f(bflo(zg[64 + l]))); }
    __syncthreads();
}
__device__ __forceinline__ void cmlp_prompt(const Args& a, const Ctx& C, int item) {
    const bf16* Z = (const bf16*)(a.ws + WS_Z); bf16* H = (bf16*)(a.ws + WS_H);
    const float* lng = a.in[12]; const float* lnb = a.in[13]; const float* wsp = a.in[14]; const float* bsp = a.in[15];
    const int g = item & 3, c = (item >> 2) & 15, b = item >> 6, tok0 = b * SEQ + c * 128;
    LAS unsigned char* lds = C.lds; const int tid = C.tid, w = C.wave, i = C.lane & 15, kq = C.lane >> 4;
    { const int s = tid >> 2, part = tid & 3;
      const bf16* zr = Z + (size_t)(tok0 + s) * NIN + ZV + part * 128; float s1 = 0.f, s2 = 0.f;
#pragma unroll 4
      for (int q = 0; q < 16; ++q) { const v4u wv = *(const v4u*)(zr + q * 8); const unsigned u4[4] = {wv.x, wv.y, wv.z, wv.w};
#pragma unroll
          for (int e = 0; e < 4; ++e) { const float x0 = gelu_f(bflo(u4[e])), x1 = gelu_f(bfhi(u4[e])); s1 += x0 + x1; s2 += x0 * x0 + x1 * x1; } }
      s1 += __shfl_xor(s1, 1); s2 += __shfl_xor(s2, 1); s1 += __shfl_xor(s1, 2); s2 += __shfl_xor(s2, 2);
      const float mean = s1 * (1.f / 512.f), var = fmaxf(s2 * (1.f / 512.f) - mean * mean, 0.f), rstd = rsqrtf(var + EPS);
      const bf16* zr2 = Z + (size_t)(tok0 + s) * NIN + ZV + g * 128 + part * 32;
      float* vout = a.out + O_VP + ((size_t)(b * 128 + s)) * 512 + g * 128 + part * 32;
#pragma unroll
      for (int q = 0; q < 4; ++q) { const v4u wv = *(const v4u*)(zr2 + q * 8); const unsigned u4[4] = {wv.x, wv.y, wv.z, wv.w};
          const int d0 = part * 32 + q * 8; float vv[8];
#pragma unroll
          for (int e = 0; e < 4; ++e) { vv[2 * e] = gelu_f(bflo(u4[e])); vv[2 * e + 1] = gelu_f(bfhi(u4[e])); }
          const f32x4 ga = *(const f32x4*)(lng + g * 128 + d0), gb = *(const f32x4*)(lng + g * 128 + d0 + 4), ba = *(const f32x4*)(lnb + g * 128 + d0), bb = *(const f32x4*)(lnb + g * 128 + d0 + 4);
#pragma unroll
          for (int e = 0; e < 8; ++e) { vv[e] = (vv[e] - mean) * rstd * (e < 4 ? ga[e & 3] : gb[e & 3]) + (e < 4 ? ba[e & 3] : bb[e & 3]);
              *(LAS unsigned short*)(lds + (d0 + e) * 272 + s * 2) = (unsigned short)f2bf(vv[e]); }
          if (c == 15) { *(f32x4*)(vout + q * 8) = (f32x4){vv[0], vv[1], vv[2], vv[3]}; *(f32x4*)(vout + q * 8 + 4) = (f32x4){vv[4], vv[5], vv[6], vv[7]}; } } }
    __syncthreads();
    { f32x4 acc[8];
#pragma unroll
      for (int db = 0; db < 8; ++db) acc[db] = (f32x4){0.f, 0.f, 0.f, 0.f};
      const int t = 16 * w + i, nks = (w >> 1) + 1;
      const float* wr = wsp + (size_t)g * 16384 + (size_t)t * 128 + kq * 8;
      for (int ks = 0; ks < nks; ++ks) { f32x4 b0 = *(const f32x4*)(wr + ks * 32), b1 = *(const f32x4*)(wr + ks * 32 + 4); const int sb = ks * 32 + kq * 8;
#pragma unroll
          for (int e = 0; e < 4; ++e) { b0[e] = (sb + e <= t) ? b0[e] : 0.f; b1[e] = (sb + 4 + e <= t) ? b1[e] : 0.f; }
          const bf16x8 B = pack8(b0, b1);
#pragma unroll
          for (int db = 0; db < 8; ++db) { const bf16x8 A = *(const LAS bf16x8*)(lds + (16 * db + i) * 272 + (ks * 32 + kq * 8) * 2); acc[db] = MFMA16(A, B, acc[db]); } }
      const float bs = bsp[g * 128 + t];
      const bf16* zu = Z + (size_t)(tok0 + t) * NIN + ZU + g * 128 + kq * 4; bf16* hp = H + (size_t)(tok0 + t) * DM + 512 + g * 128 + kq * 4;
#pragma unroll
      for (int db = 0; db < 8; ++db) { const f32x4 u = load4bf(zu + 16 * db);
          store4bf(hp + 16 * db, (f32x4){gelu_f(u[0]) * (acc[db][0] + bs), gelu_f(u[1]) * (acc[db][1] + bs), gelu_f(u[2]) * (acc[db][2] + bs), gelu_f(u[3]) * (acc[db][3] + bs)}); } }
    __syncthreads();
}
__device__ __forceinline__ void cmlp_sample(const Args& a, const Ctx& C, int b) {
    const bf16* Z = (const bf16*)(a.ws + WS_Z); bf16* H = (bf16*)(a.ws + WS_H);
    const float* lng = a.in[12]; const float* lnb = a.in[13]; const float* wsp = a.in[14]; const float* bsp = a.in[15];
    const int m0 = MP + b * DSEQ, col = C.tid, g = col >> 7;
    LAS float* RED = (LAS float*)C.lds;
    float x[8];
#pragma unroll
    for (int t = 0; t < 8; ++t) x[t] = gelu_f(bflo(Z[(size_t)(m0 + t) * NIN + ZV + col]));
#pragma unroll
    for (int t = 0; t < 8; ++t) { const float s1 = wave_sum(x[t]), s2 = wave_sum(x[t] * x[t]); if (C.lane == 0) { RED[C.wave * 16 + t] = s1; RED[C.wave * 16 + 8 + t] = s2; } }
    __syncthreads();
    const float lg = lng[col], lb = lnb[col];
    float v[8];
#pragma unroll
    for (int t = 0; t < 8; ++t) { float s1 = 0.f, s2 = 0.f;
#pragma unroll
        for (int ww = 0; ww < 8; ++ww) { s1 += RED[ww * 16 + t]; s2 += RED[ww * 16 + 8 + t]; }
        const float mean = s1 * (1.f / 512.f), var = fmaxf(s2 * (1.f / 512.f) - mean * mean, 0.f), rstd = rsqrtf(var + EPS);
        v[t] = (x[t] - mean) * rstd * lg + lb;
        a.out[O_VS + ((size_t)(b * DSEQ + t)) * 512 + col] = v[t]; }
#pragma unroll
    for (int t = 0; t < 8; ++t) { float mix = bsp[g * 128 + t];
#pragma unroll
        for (int s = 0; s <= t; ++s) mix += wsp[(size_t)g * 16384 + t * 128 + s] * v[s];
        const float u = gelu_f(bflo(Z[(size_t)(m0 + t) * NIN + ZU + col]));
        H[(size_t)(m0 + t) * DM + 512 + col] = (bf16)f2bf(u * mix); }
    __syncthreads();
}
__device__ __forceinline__ void phase_m1(const Args& a, const Ctx& C) {
    constexpr int N_A = NBP * 4 * 32, N_S = NBS * 4, N_C = NBP * 16 * 4, N_D = NBS;
    for (int it = C.vcu; it < N_A + N_S + N_C + N_D; it += C.G) {
        if (it < N_A) hgrn_pass_a(a, C, it);
        else if (it < N_A + N_S) hgrn_sample(a, C, it - N_A);
        else if (it < N_A + N_S + N_C) cmlp_prompt(a, C, it - N_A - N_S);
        else cmlp_sample(a, C, it - N_A - N_S - N_C);
    }
}
__device__ __forceinline__ void phase_m2(const Args& a, const Ctx& C) {
    float* DS = (float*)(a.ws + WS_DS); const float* DEC = (const float*)(a.ws + WS_DEC);
    for (int e = C.vcu * NTHR + C.tid; e < 32 * 4096; e += C.G * NTHR) {
        const int bh = e >> 12, idx = e & 4095, v = idx >> 5, k4 = (idx & 31) * 4;
        f32x4 S = (f32x4){0.f, 0.f, 0.f, 0.f};
        float* p = DS + (size_t)bh * 32 * 16384 + v * 128 + k4; const float* dp = DEC + (size_t)bh * 32 * 128 + k4;
#pragma unroll 8
        for (int n = 0; n < 32; ++n) { const f32x4 ds = *(const f32x4*)(p + (size_t)n * 16384), dc = *(const f32x4*)(dp + n * 128);
            *(f32x4*)(p + (size_t)n * 16384) = S; S = dc * S + ds; }
        float* so = a.out + O_SP + (size_t)bh * 16384 + v;
#pragma unroll
        for (int c = 0; c < 4; ++c) so[(size_t)(k4 + c) * 128] = S[c];
    }
}
__device__ __forceinline__ void hgrn_pass_c(const Args& a, const Ctx& C, int item) {
    const bf16* Z = (const bf16*)(a.ws + WS_Z); bf16* H = (bf16*)(a.ws + WS_H); const float* DS = (const float*)(a.ws + WS_DS);
    const bf16* QDG = (const bf16*)((unsigned char*)a.out + OUT_QD); const float* OI = (const float*)((unsigned char*)a.out + OUT_OI); const float* gnw = a.in[11];
    const int bh = item >> 5, n = item & 31, b = bh >> 2, h = bh & 3, tok0 = b * SEQ + n * 64;
    const int w = C.wave, tb = w & 3, vh = w >> 2, i = C.lane & 15, kq = C.lane >> 4;
    f32x4 acc[4];
#pragma unroll
    for (int vb = 0; vb < 4; ++vb) acc[vb] = (f32x4){0.f, 0.f, 0.f, 0.f};
    const int t = 16 * tb + i;
    const bf16* qp = QDG + (size_t)(tok0 + t) * 512 + h * 128 + kq * 8;
    const float* sp = DS + (size_t)item * 16384 + (size_t)(64 * vh + i) * 128 + kq * 8;
#pragma unroll
    for (int ks = 0; ks < 4; ++ks) { const bf16x8 B = *(const bf16x8*)(qp + ks * 32);
#pragma unroll
        for (int vb = 0; vb < 4; ++vb) { const float* p = sp + vb * 16 * 128 + ks * 32; const bf16x8 A = pack8(*(const f32x4*)p, *(const f32x4*)(p + 4)); acc[vb] = MFMA16(A, B, acc[vb]); } }
    float ss = 0.f; f32x4 o[4];
#pragma unroll
    for (int vb = 0; vb < 4; ++vb) { const int v0 = 64 * vh + 16 * vb + kq * 4; o[vb] = acc[vb] + *(const f32x4*)(OI + (size_t)(tok0 + t) * 512 + h * 128 + v0);
        ss += (o[vb][0] * o[vb][0] + o[vb][1] * o[vb][1]) + (o[vb][2] * o[vb][2] + o[vb][3] * o[vb][3]); }
    ss += __shfl_xor(ss, 16); ss += __shfl_xor(ss, 32);
    LAS float* SS = (LAS float*)C.lds;
    if (C.lane < 16) SS[w * 16 + C.lane] = ss;
    __syncthreads();
    const float rs = rsqrtf((SS[w * 16 + i] + SS[(w ^ 4) * 16 + i]) * (1.f / 128.f) + EPS);
#pragma unroll
    for (int vb = 0; vb < 4; ++vb) { const int v0 = 64 * vh + 16 * vb + kq * 4; const f32x4 gw = *(const f32x4*)(gnw + v0), zg = load4bf(Z + (size_t)(tok0 + t) * NIN + ZG + h * 128 + v0);
        store4bf(H + (size_t)(tok0 + t) * DM + h * 128 + v0, (f32x4){o[vb][0] * rs * gw[0] * silu2_f(zg[0]), o[vb][1] * rs * gw[1] * silu2_f(zg[1]), o[vb][2] * rs * gw[2] * silu2_f(zg[2]), o[vb][3] * rs * gw[3] * silu2_f(zg[3])}); }
    __syncthreads();
}
__device__ __forceinline__ void phase_m3(const Args& a, const Ctx& C) {
    for (int it = C.vcu; it < NBP * 4 * 32; it += C.G) hgrn_pass_c(a, C, it);
}

__global__ void __launch_bounds__(NTHR, 2) mk_fwd(Args args) {
    extern __shared__ __attribute__((aligned(16))) unsigned char lds_raw[];
    Ctx C;
    C.lds = (LAS unsigned char*)lds_raw;
    C.tid = threadIdx.x; C.lane = C.tid & 63; C.wave = __builtin_amdgcn_readfirstlane(C.tid >> 6);
    C.G = gridDim.x; { const int bx = blockIdx.x; C.vcu = (C.G % 8 == 0) ? (bx % 8) * (C.G / 8) + bx / 8 : bx; }
    volatile LAS unsigned* MISC = (volatile LAS unsigned*)(C.lds + MISC_OFF);
    for (int u = C.tid; u < (LDS_BYTES - LDSCTL_OFF) / 4; u += NTHR) ((LAS unsigned*)(C.lds + LDSCTL_OFF))[u] = 0u;
    __syncthreads();
    unsigned* barw = (unsigned*)(args.ws + WS_CTL) + CW_BAR;
    const int lo = args.ph_lo, hi = args.ph_hi;
    const bool multi = (hi - lo) > 1;
    XcdBarrier bar; bar.bar = barw; bar.x = 0; bar.st = nullptr;
    if (multi) bar = xcd_barrier_post(barw, MISC + 8);
    if (args.use_cg) cg::this_grid().sync();
#define IN(k) (lo <= (k) && (k) < hi)
#define SEAM(k) do { if (IN(k) && IN((k) + 1)) xcd_barrier(bar); } while (0)
    bf16* H = (bf16*)(args.ws + WS_H); bf16* Zb = (bf16*)(args.ws + WS_Z);
    if (IN(0)) { phase_p0(args, C); SEAM(0); }
    if (IN(1)) { phase_mod(args, C); SEAM(1); }
    if (IN(2)) { phase_p1(args, C); SEAM(2); }
    if (IN(3)) { pg8::Gemm g{H, (const bf16*)(args.ws + WS_WIN), MT, NIN, DM}; pg8::StaticOrder S; S.init(MT, NIN, C.G, (int)blockIdx.x);
        pg8::EpiStore E{Zb, NIN};
        pg8::gemm_phase<pg8::EpiStore, pg8::StaticOrder, true, true>(C.lds, g, S, E); SEAM(3); }
    if (IN(4)) { phase_m1(args, C); SEAM(4); }
    if (IN(5)) { phase_m2(args, C); SEAM(5); }
    if (IN(6)) { phase_m3(args, C); SEAM(6); }
    if (IN(7)) { pg8::Gemm g{H, (const bf16*)(args.ws + WS_WOUT), MT, DM, DM}; pg8::StaticOrder S; S.init(MT, DM, C.G, (int)blockIdx.x);
        pg8::EpiStore E{(bf16*)(args.ws + WS_MB), DM};
        pg8::gemm_phase<pg8::EpiStore, pg8::StaticOrder, true, true>(C.lds, g, S, E); SEAM(7); }
    if (IN(8)) { phase_p5(args, C); SEAM(8); }
    if (IN(9)) { pg8::Gemm g{H, (const bf16*)(args.ws + WS_WGU), MT, NGU, DM}; pg8::StaticOrder S; S.init(MT, NGU, C.G, (int)blockIdx.x);
        pg8::EpiSwiGLU E{(bf16*)(args.ws + WS_ACT), DFF};
        pg8::gemm_phase<pg8::EpiSwiGLU, pg8::StaticOrder, true, true>(C.lds, g, S, E); SEAM(9); }
    if (IN(10)) { pg8::Gemm g{(const bf16*)(args.ws + WS_ACT), (const bf16*)(args.ws + WS_WDN), MT, DM, DFF}; pg8::StaticOrder S; S.init(MT, DM, C.G, (int)blockIdx.x);
        pg8::EpiStore E{(bf16*)(args.ws + WS_FB), DM};
        pg8::gemm_phase<pg8::EpiStore, pg8::StaticOrder, true, true>(C.lds, g, S, E); SEAM(10); }
    if (IN(11)) { phase_p8(args, C); }
#undef IN
#undef SEAM
}

extern "C" void kernel_launch(void* const* d_in, const int* in_sizes, int n_in, void* d_out, int out_size, void* d_ws, size_t ws_size, hipStream_t stream) {
    static int grid = 0;
    if (grid == 0) {
        if (n_in != 22 || ws_size < WS_END) { fprintf(stderr, "kernel_launch: unexpected inputs (n_in %d, ws %zu)\n", n_in, ws_size); grid = -1; return; }
        int dev = 0, cus = 0, per_cu = 0;
        if (hipGetDevice(&dev) != hipSuccess || hipDeviceGetAttribute(&cus, hipDeviceAttributeMultiprocessorCount, dev) != hipSuccess) { grid = -1; return; }
        if (hipFuncSetAttribute((const void*)mk_fwd, hipFuncAttributeMaxDynamicSharedMemorySize, LDS_BYTES) != hipSuccess) { fprintf(stderr, "kernel_launch: hipFuncSetAttribute failed\n"); grid = -1; return; }
        if (hipOccupancyMaxActiveBlocksPerMultiprocessor(&per_cu, (const void*)mk_fwd, NTHR, LDS_BYTES) != hipSuccess || per_cu < 1) { fprintf(stderr, "kernel_launch: occupancy query says %d\n", per_cu); per_cu = 1; }
        (void)hipGetLastError();
        grid = cus;
    }
    if (grid < 0) return;
    (void)hipMemsetAsync((char*)d_ws + WS_CTL, 0, CTL_ZERO_BYTES, stream);
    Args a{};
    for (int i = 0; i < 22; ++i) a.in[i] = (const float*)d_in[i];
    a.out = (float*)d_out; a.ws = (unsigned char*)d_ws; a.use_cg = 0; a.pad = 0;
#if MK_N_LAUNCHES == 1
    a.ph_lo = 0; a.ph_hi = NPH;
    void* kargs[] = {&a};
    hipError_t e = hipLaunchCooperativeKernel((const void*)mk_fwd, dim3(grid), dim3(NTHR), kargs, LDS_BYTES, stream);
    if (e != hipSuccess) fprintf(stderr, "kernel_launch: cooperative launch failed: %s (grid %d)\n", hipGetErrorString(e), grid);
#else
    for (int p = 0; p < NPH; ++p) { a.ph_lo = p; a.ph_hi = p + 1; hipLaunchKernelGGL(mk_fwd, dim3(grid), dim3(NTHR), LDS_BYTES, stream, a); }
#endif
}
```

```cpp
#define MK_N_LAUNCHES 1
#include <hip/hip_runtime.h>
#include <hip/hip_cooperative_groups.h>
#include <cstdio>
#include <cstdint>
namespace pg8 {
#define PG8_LAS __attribute__((address_space(3)))
typedef unsigned short bf16_t;
typedef short bf16x8 __attribute__((ext_vector_type(8)));
typedef float f32x4 __attribute__((ext_vector_type(4)));
typedef unsigned u32x4 __attribute__((ext_vector_type(4)));
constexpr int BM = 256, BK = 64, HALF = 128, HTB = HALF * BK * 2  , STAGE_BYTES = 8 * HTB, NXCD = 8, WGM = 8;

__host__ __device__ __forceinline__ int lds_byte(int r, int c) { const int st = (r >> 4) * 2 + (c >> 5), rr = r & 15, cc = c & 31, ob = rr * 64 + cc * 2; return st * 1024 + (ob ^ (((ob >> 9) & 1) << 5)); }
__host__ __device__ __forceinline__ void stage_rc(int b, int& R, int& C) { const int st = b / 1024, sb = b % 1024, swz = sb ^ (((sb >> 9) & 1) << 5); R = (st >> 1) * 16 + swz / 64; C = (st & 1) * 32 + (swz % 64) / 2; }
__host__ __device__ __forceinline__ int perm32(int rho) { const int n = rho >> 4, i = rho & 15; return 8 * (i >> 2) + 4 * n + (i & 3); }

struct Unit { int pm, pn; };
struct Gemm { const bf16_t* A; const bf16_t* Bt; int M, N, K; };

struct StaticOrder {
    int nM, nN, nwg, G, c;
    __host__ __device__ void init(int M, int N, int G_, int c_) { nM = M / BM; nN = N / BM; nwg = nM * nN; G = G_; c = c_; }
    __host__ __device__ bool next(int i, Unit& u) const {
        const long L = (long)i * G + c; if (L >= nwg) return false;
        int wgid = (int)L; { const int q = nwg / NXCD, r = nwg % NXCD, xcd = wgid % NXCD, off = wgid / NXCD; wgid = (xcd < r ? xcd * (q + 1) : r * (q + 1) + (xcd - r) * q) + off; }
        const int nig = WGM * nN, gid = wgid / nig, fm = gid * WGM, gsz = (nM - fm) < WGM ? (nM - fm) : WGM;
        u.pm = fm + ((wgid % nig) % gsz); u.pn = (wgid % nig) / gsz; return true;
    }
    __device__ __forceinline__ void a_ready(const Unit&) const {}
    __device__ __forceinline__ void done(const Unit&) const {}
};
__device__ __forceinline__ unsigned cvt_pk_bf16(float lo, float hi) { unsigned r; asm volatile("v_cvt_pk_bf16_f32 %0, %1, %2" : "=v"(r) : "v"(lo), "v"(hi)); return r; }
struct EpiStore {
    static constexpr bool PERM = true, AFTER_DRAIN = false;
    bf16_t* O; int ldc;
    __device__ __forceinline__ void operator()(const f32x4 (&acc)[2][2][4][2], const Unit& u, int wr, int wc, int fr, int fq) const {
        const int row0 = u.pm * BM + wr * 64 + fr, col0 = u.pn * BM + wc * 32 + 8 * fq;
#pragma unroll
        for (int ai = 0; ai < 2; ++ai)
#pragma unroll
            for (int m = 0; m < 4; ++m) { bf16_t* rowp = O + (size_t)(row0 + ai * HALF + m * 16) * ldc + col0;
#pragma unroll
                for (int bj = 0; bj < 2; ++bj) { const f32x4 v0 = acc[ai][bj][m][0], v1 = acc[ai][bj][m][1];
                    u32x4 w; w.x = cvt_pk_bf16(v0[0], v0[1]); w.y = cvt_pk_bf16(v0[2], v0[3]); w.z = cvt_pk_bf16(v1[0], v1[1]); w.w = cvt_pk_bf16(v1[2], v1[3]);
                    *(u32x4*)(rowp + bj * HALF) = w; } }
    }
};
__device__ __forceinline__ float silu_f(float x) { return x * __builtin_amdgcn_rcpf(1.f + __expf(-x)); }
struct EpiSwiGLU {
    static constexpr bool PERM = true, AFTER_DRAIN = false;
    bf16_t* O; int ldc;
    __device__ __forceinline__ void operator()(const f32x4 (&acc)[2][2][4][2], const Unit& u, int wr, int wc, int fr, int fq) const {
        const int row0 = u.pm * BM + wr * 64 + fr, col0 = u.pn * HALF + wc * 32 + 8 * fq;
#pragma unroll
        for (int ai = 0; ai < 2; ++ai)
#pragma unroll
            for (int m = 0; m < 4; ++m) { bf16_t* rowp = O + (size_t)(row0 + ai * HALF + m * 16) * ldc + col0;
                const f32x4 g0 = acc[ai][0][m][0], g1 = acc[ai][0][m][1], u0 = acc[ai][1][m][0], u1 = acc[ai][1][m][1];
                u32x4 w;
                w.x = cvt_pk_bf16(silu_f(g0[0]) * u0[0], silu_f(g0[1]) * u0[1]); w.y = cvt_pk_bf16(silu_f(g0[2]) * u0[2], silu_f(g0[3]) * u0[3]);
                w.z = cvt_pk_bf16(silu_f(g1[0]) * u1[0], silu_f(g1[1]) * u1[1]); w.w = cvt_pk_bf16(silu_f(g1[2]) * u1[2], silu_f(g1[3]) * u1[3]);
                *(u32x4*)rowp = w; }
    }
};
template <class Epi, class Sched, bool ALIGN_EPI = false, bool SP2 = false>
__device__ __forceinline__ void gemm_phase(PG8_LAS unsigned char* lds, const Gemm g, const Sched& S, const Epi& E) {
    const int tid = threadIdx.x, wid = __builtin_amdgcn_readfirstlane(tid >> 6), lane = tid & 63, wr = wid >> 2, wc = wid & 3, fr = lane & 15, fq = lane >> 4;
    const int K = g.K, nt = K / BK;
    unsigned voffA[2], voffB[2];
#pragma unroll
    for (int i = 0; i < 2; ++i) { int R, C; stage_rc(tid * 16 + i * 8192, R, C); const int Rb = Epi::PERM ? ((R & ~31) + perm32(R & 31)) : R;
        voffA[i] = (unsigned)(R * K + C) * 2u; voffB[i] = (unsigned)(Rb * K + C) * 2u; }
    const size_t kstep = (size_t)(BK * 2);
    const size_t hstep = (size_t)HALF * K * 2;
    const size_t tstep = 2 * hstep;
    const unsigned ldsw = (unsigned)wid * 1024u;
    const int aoff = lds_byte(wr * 64 + fr, fq * 8), boff = lds_byte(wc * 32 + fr, fq * 8);
#define PG8_SA(b, h) (((b) * 2 + (h)) * HTB)
#define PG8_SB(b, h) ((4 + (b) * 2 + (h)) * HTB)
#define PG8_STAGE(bufoff, gbase, voff) do { _Pragma("unroll") for (int _i = 0; _i < 2; ++_i) \
        __builtin_amdgcn_global_load_lds((const unsigned*)((const char*)(gbase) + (voff)[_i]), (PG8_LAS unsigned*)(lds + (bufoff) + ldsw + _i * 8192), 16, 0, 0); } while (0)
#define PG8_LDA(dst, b, h) do { _Pragma("unroll") for (int m = 0; m < 4; ++m) _Pragma("unroll") for (int k = 0; k < 2; ++k) dst[m][k] = *(const PG8_LAS bf16x8*)(lds + PG8_SA(b, h) + aoff + m * 2048 + k * 1024); } while (0)
#define PG8_LDB(dst, b, h) do { _Pragma("unroll") for (int n = 0; n < 2; ++n) _Pragma("unroll") for (int k = 0; k < 2; ++k) dst[n][k] = *(const PG8_LAS bf16x8*)(lds + PG8_SB(b, h) + boff + n * 2048 + k * 1024); } while (0)
#define PG8_MMA(ai, bj, At, Bt) do { __builtin_amdgcn_s_setprio(1); _Pragma("unroll") for (int m = 0; m < 4; ++m) _Pragma("unroll") for (int n = 0; n < 2; ++n) _Pragma("unroll") for (int k = 0; k < 2; ++k) \
        acc[ai][bj][m][n] = __builtin_amdgcn_mfma_f32_16x16x32_bf16(Bt[n][k], At[m][k], acc[ai][bj][m][n], 0, 0, 0); __builtin_amdgcn_s_setprio(0); } while (0)
#define PG8_WAIT_V(n) asm volatile("s_waitcnt vmcnt(" #n ")" ::: "memory")
#define PG8_WAIT_L(n) asm volatile("s_waitcnt lgkmcnt(" #n ")" ::: "memory")
#define PG8_BAR __builtin_amdgcn_s_barrier()
#define PG8_SCHED __builtin_amdgcn_sched_barrier(0)
    Unit cur, nxt; int ui = 0;
    if (!S.next(0, cur)) return;
    f32x4 acc[2][2][4][2];
#pragma unroll
    for (int a = 0; a < 2; ++a)
#pragma unroll
        for (int b = 0; b < 2; ++b)
#pragma unroll
            for (int m = 0; m < 4; ++m)
#pragma unroll
                for (int n = 0; n < 2; ++n) acc[a][b][m][n] = (f32x4){0.f, 0.f, 0.f, 0.f};
    bf16x8 At[4][2], B0[2][2], B1[2][2];
    const char* cA = (const char*)g.A + (size_t)cur.pm * tstep; const char* cB = (const char*)g.Bt + (size_t)cur.pn * tstep;
    S.a_ready(cur);
    if constexpr (SP2) {
        PG8_STAGE(PG8_SB(0, 0), cB, voffB); PG8_STAGE(PG8_SB(0, 1), cB + hstep, voffB); PG8_STAGE(PG8_SA(0, 0), cA, voffA); PG8_STAGE(PG8_SA(0, 1), cA + hstep, voffA);
        if (wr == 1) PG8_BAR;
        PG8_WAIT_V(2); PG8_BAR;
        PG8_STAGE(PG8_SB(1, 0), cB + kstep, voffB); PG8_STAGE(PG8_SA(1, 0), cA + kstep, voffA); PG8_STAGE(PG8_SB(1, 1), cB + hstep + kstep, voffB);
        PG8_WAIT_V(6); PG8_BAR;
    } else {
        PG8_STAGE(PG8_SB(0, 0), cB, voffB); PG8_STAGE(PG8_SA(0, 0), cA, voffA); PG8_STAGE(PG8_SB(0, 1), cB + hstep, voffB); PG8_STAGE(PG8_SA(0, 1), cA + hstep, voffA);
        if (wr == 1) PG8_BAR;
        PG8_WAIT_V(4); PG8_BAR;
        PG8_STAGE(PG8_SB(1, 0), cB + kstep, voffB); PG8_STAGE(PG8_SA(1, 0), cA + kstep, voffA); PG8_STAGE(PG8_SB(1, 1), cB + hstep + kstep, voffB);
        PG8_WAIT_V(6); PG8_BAR;
    }
    for (;;) {
        const bool has_next = S.next(ui + 1, nxt);
        const char* nA = has_next ? (const char*)g.A + (size_t)nxt.pm * tstep : cA; const char* nB = has_next ? (const char*)g.Bt + (size_t)nxt.pn * tstep : cB;
        for (int t = 0; t < nt; t += 2) {
            const bool last = (t == nt - 2);
            const char* a1 = cA + (size_t)(t + 1) * kstep;
            const char* a2 = last ? nA : cA + (size_t)(t + 2) * kstep; const char* b2 = last ? nB : cB + (size_t)(t + 2) * kstep;
            const char* a3 = a2 + kstep; const char* b3 = b2 + kstep;
            if (last && has_next) S.a_ready(nxt);
            if constexpr (SP2) {
            PG8_LDB(B0, 0, 0); PG8_LDB(B1, 0, 1); PG8_SCHED; PG8_LDA(At, 0, 0); PG8_STAGE(PG8_SA(1, 1), a1 + hstep, voffA);
            PG8_WAIT_V(8); PG8_WAIT_L(0); PG8_BAR; PG8_MMA(0, 0, At, B0); PG8_MMA(0, 1, At, B1); PG8_BAR; PG8_SCHED;
            PG8_LDA(At, 0, 1); PG8_STAGE(PG8_SB(0, 0), b2, voffB); PG8_STAGE(PG8_SB(0, 1), b2 + hstep, voffB); PG8_STAGE(PG8_SA(0, 0), a2, voffA);
            PG8_WAIT_V(8); PG8_WAIT_L(0); PG8_BAR; PG8_MMA(1, 0, At, B0); PG8_MMA(1, 1, At, B1); PG8_BAR; PG8_SCHED;
            PG8_LDB(B0, 1, 0); PG8_LDB(B1, 1, 1); PG8_SCHED; PG8_LDA(At, 1, 0); PG8_STAGE(PG8_SA(0, 1), a2 + hstep, voffA);
            PG8_WAIT_V(8); PG8_WAIT_L(0); PG8_BAR; PG8_MMA(0, 0, At, B0); PG8_MMA(0, 1, At, B1); PG8_BAR; PG8_SCHED;
            PG8_LDA(At, 1, 1); PG8_STAGE(PG8_SB(1, 0), b3, voffB); PG8_STAGE(PG8_SB(1, 1), b3 + hstep, voffB); PG8_STAGE(PG8_SA(1, 0), a3, voffA);
            PG8_WAIT_V(8); PG8_WAIT_L(0); PG8_BAR; PG8_MMA(1, 0, At, B0); PG8_MMA(1, 1, At, B1); PG8_BAR; PG8_SCHED;
            } else {
            PG8_LDB(B0, 0, 0); PG8_SCHED; PG8_LDA(At, 0, 0); PG8_STAGE(PG8_SA(1, 1), a1 + hstep, voffA);
            PG8_WAIT_L(8); PG8_BAR; PG8_WAIT_L(0); PG8_MMA(0, 0, At, B0); PG8_BAR; PG8_SCHED;
            PG8_LDB(B1, 0, 1); PG8_STAGE(PG8_SB(0, 0), b2, voffB);
            PG8_BAR; PG8_WAIT_L(0); PG8_MMA(0, 1, At, B1); PG8_BAR;
            PG8_LDA(At, 0, 1); PG8_STAGE(PG8_SA(0, 0), a2, voffA);
            PG8_BAR; PG8_WAIT_L(0); PG8_MMA(1, 0, At, B0); PG8_BAR; PG8_SCHED;
            PG8_STAGE(PG8_SB(0, 1), b2 + hstep, voffB);
            PG8_WAIT_V(6); PG8_BAR; PG8_MMA(1, 1, At, B1); PG8_BAR;
            PG8_LDB(B0, 1, 0); PG8_SCHED; PG8_LDA(At, 1, 0); PG8_STAGE(PG8_SA(0, 1), a2 + hstep, voffA);
            PG8_WAIT_L(8); PG8_BAR; PG8_WAIT_L(0); PG8_MMA(0, 0, At, B0); PG8_BAR; PG8_SCHED;
            PG8_LDB(B1, 1, 1); PG8_STAGE(PG8_SB(1, 0), b3, voffB);
            PG8_BAR; PG8_WAIT_L(0); PG8_MMA(0, 1, At, B1); PG8_BAR;
            PG8_LDA(At, 1, 1); PG8_STAGE(PG8_SA(1, 0), a3, voffA);
            PG8_BAR; PG8_WAIT_L(0); PG8_MMA(1, 0, At, B0); PG8_BAR; PG8_SCHED;
            PG8_STAGE(PG8_SB(1, 1), b3 + hstep, voffB);
            PG8_WAIT_V(6); PG8_BAR; PG8_MMA(1, 1, At, B1); PG8_BAR;
            }
        }
        if constexpr (ALIGN_EPI) { if (wr == 0) PG8_BAR; }
        if constexpr (!Epi::AFTER_DRAIN) { E(acc, cur, wr, wc, fr, fq); S.done(cur); }
        if (!has_next) break;
#pragma unroll
        for (int a = 0; a < 2; ++a)
#pragma unroll
            for (int b = 0; b < 2; ++b)
#pragma unroll
                for (int m = 0; m < 4; ++m)
#pragma unroll
                    for (int n = 0; n < 2; ++n) acc[a][b][m][n] = (f32x4){0.f, 0.f, 0.f, 0.f};
        cur = nxt; cA = nA; cB = nB; ++ui;
        if constexpr (ALIGN_EPI) { if (wr == 1) PG8_BAR; }
    }
    PG8_WAIT_V(0);
    if constexpr (!ALIGN_EPI) { if (wr == 0) PG8_BAR; }
    PG8_BAR;
    if constexpr (Epi::AFTER_DRAIN) { E.fused(acc, cur, wr, wc, fr, fq, lds, wid, lane); S.done(cur); }
#undef PG8_SA
#undef PG8_SB
#undef PG8_STAGE
#undef PG8_LDA
#undef PG8_LDB
#undef PG8_MMA
#undef PG8_WAIT_V
#undef PG8_WAIT_L
#undef PG8_BAR
#undef PG8_SCHED
}
}

#define GAS __attribute__((address_space(1)))
#define LAS __attribute__((address_space(3)))
typedef unsigned short bf16;
typedef unsigned v4u __attribute__((ext_vector_type(4)));
typedef unsigned v2u __attribute__((ext_vector_type(2)));
typedef float f32x4 __attribute__((ext_vector_type(4)));
typedef short bf16x8 __attribute__((ext_vector_type(8)));
typedef GAS unsigned gu32;
#define RLX_AGENT __ATOMIC_RELAXED, __HIP_MEMORY_SCOPE_AGENT
#define LDS_WAIT() asm volatile("s_waitcnt lgkmcnt(0)" ::: "memory")
#define VM_WAIT() asm volatile("s_waitcnt vmcnt(0)" ::: "memory")
__device__ __forceinline__ unsigned f2bf(float f) { unsigned u = __builtin_bit_cast(unsigned, f); return (u + 0x7fffu + ((u >> 16) & 1u)) >> 16; }
__device__ __forceinline__ unsigned pk2(float lo, float hi) { return f2bf(lo) | (f2bf(hi) << 16); }
#define XB_TMO      128
#define XB_XCNT(j)  (256  + 64 * (j))
#define XB_XSUB(j)  (1280 + 64 * (j))
#define XB_XGEN(j)  (2304 + 64 * (j))
#define XB_TOP      3328
#define XB_TOPGEN   3392
#define XCD_BAR_WORDS 3456
#define XB_SPIN_CAP (1u << 18)

__device__ __forceinline__ unsigned xb_ld(unsigned* p)              { return __hip_atomic_load(p, __ATOMIC_RELAXED, __HIP_MEMORY_SCOPE_AGENT); }
__device__ __forceinline__ unsigned xb_add(unsigned* p, unsigned v) { return __hip_atomic_fetch_add(p, v, __ATOMIC_RELAXED, __HIP_MEMORY_SCOPE_AGENT); }
__device__ __forceinline__ unsigned xb_xcc_id() { return (unsigned)__builtin_amdgcn_s_getreg((3 << 11) | 20) & 0xFu; }
#define XB_SPIN(cond, bar) do { unsigned _sp = 0; while (cond) { __builtin_amdgcn_s_sleep(1); \
    if ((++_sp & 255u) == 0u) { if (xb_ld(&(bar)[XB_TMO])) break; if (_sp > XB_SPIN_CAP) { atomicAdd(&(bar)[XB_TMO], 1u); break; } } } } while (0)

struct XcdBarrier {
    unsigned* bar; unsigned x;
    volatile LAS unsigned* st;
};

__device__ __forceinline__ XcdBarrier xcd_barrier_post(unsigned* bar, volatile LAS unsigned* st) {
    XcdBarrier b; b.bar = bar; b.x = xb_xcc_id(); b.st = st;
    if (threadIdx.x == 0) (void)xb_add(&bar[XB_XCNT(b.x)], 1u);
    return b;
}
__device__ __forceinline__ void xcd_barrier_complete(unsigned* bar, unsigned x, unsigned& nloc, unsigned& nx) {
    const unsigned G = gridDim.x * gridDim.y * gridDim.z;
    unsigned sum, cnt, mine, sp = 0u;
    for (;;) {
        sum = 0u; cnt = 0u; mine = 0u;
#pragma unroll
        for (unsigned j = 0; j < 16; ++j) { const unsigned c = xb_ld(&bar[XB_XCNT(j)]); sum += c; cnt += (c > 0u) ? 1u : 0u; mine = (j == x) ? c : mine; }
        if (sum == G) break;
        __builtin_amdgcn_s_sleep(1);
        if ((++sp & 255u) == 0u) { if (xb_ld(&bar[XB_TMO])) break; if (sp > XB_SPIN_CAP) { atomicAdd(&bar[XB_TMO], 1u); break; } }
    }
    nloc = mine > 0u ? mine : 1u; nx = cnt > 0u ? cnt : 1u;
}

__device__ __forceinline__ void xcd_barrier(const XcdBarrier& b) {
    asm volatile("s_waitcnt vmcnt(0)" ::: "memory");
    __syncthreads();
    if (threadIdx.x == 0) {
        unsigned* bar = b.bar;
        __builtin_amdgcn_s_waitcnt(0);
        unsigned nloc = b.st[0], nx = b.st[1];
        if (nloc == 0u) { xcd_barrier_complete(bar, b.x, nloc, nx); b.st[0] = nloc; b.st[1] = nx; }
        const unsigned old = xb_add(&bar[XB_XSUB(b.x)], 1u);
        const unsigned gen = old / nloc;
        if (old + 1u == (gen + 1u) * nloc) {
            __builtin_amdgcn_fence(__ATOMIC_RELEASE, "agent");
            asm volatile("s_waitcnt vmcnt(0)" ::: "memory");
            const unsigned og = xb_add(&bar[XB_TOP], 1u);
            const unsigned tg = og / nx;
            if (og + 1u == (tg + 1u) * nx) xb_add(&bar[XB_TOPGEN], 1u);
            else XB_SPIN(xb_ld(&bar[XB_TOPGEN]) == tg, bar);
            __builtin_amdgcn_fence(__ATOMIC_ACQUIRE, "agent");
            xb_add(&bar[XB_XGEN(b.x)], 1u);
            asm volatile("s_waitcnt vmcnt(0)" ::: "memory");
        } else {
            XB_SPIN(xb_ld(&bar[XB_XGEN(b.x)]) == gen, bar);
            __builtin_amdgcn_fence(__ATOMIC_ACQUIRE, "agent");
            asm volatile("s_waitcnt vmcnt(0)" ::: "memory");
        }
    }
    __syncthreads();
}

namespace cg = cooperative_groups;
constexpr int NWAVES = 8, NTHR = 512;
constexpr int DM = 1024, NBP = 8, SEQ = 2048, NBS = 128, DSEQ = 8, MP = NBP * SEQ, MS = NBS * DSEQ, MT = MP + MS, NSEQ = NBP + NBS;
constexpr int NIN = 3072, DFF = 2816, NGU = 2 * DFF, NMOD = 6 * DM;
constexpr int ZQ = 0, ZF = 512, ZI = 1024, ZG = 1536, ZU = 2048, ZV = 2560;
constexpr float EPS = 1e-6f;
constexpr size_t O_Y = 0, O_SP = (size_t)MT * DM, O_SS = O_SP + (size_t)NBP * 4 * 16384, O_VP = O_SS + (size_t)NBS * 4 * 16384, O_VS = O_VP + (size_t)NBP * 128 * 512;
constexpr size_t MiB = 1u << 20;
constexpr size_t OUT_QD = 0, OUT_OI = 16 * MiB;
constexpr size_t WS_CTL = 0, CTL_ZERO_BYTES = 64 * 1024;
constexpr size_t WS_WIN = 1 * MiB, WS_WOUT = 7 * MiB, WS_WGU = 9 * MiB, WS_WDN = 20 * MiB, WS_MOD = 26 * MiB, WS_SC = 30 * MiB, WS_DEC = 31 * MiB;
constexpr size_t WS_H = 32 * MiB, WS_Z = 66 * MiB, WS_DS = 168 * MiB, WS_END = 232 * MiB;
constexpr size_t WS_ACT = WS_Z, WS_MB = WS_DS, WS_FB = WS_DS;
static_assert(WS_WDN + (size_t)DM * DFF * 2 <= WS_MOD && WS_MOD + (size_t)NSEQ * NMOD * 4 <= WS_SC && WS_H + (size_t)MT * DM * 2 <= WS_Z && WS_Z + (size_t)MT * NIN * 2 <= WS_DS, "ws map");
static_assert(WS_ACT + (size_t)MT * DFF * 2 <= WS_DS && WS_DS + (size_t)1024 * 16384 * 4 <= WS_END, "ws map 2");
constexpr int CW_BAR = 4096;
constexpr int RING_BYTES = 131072, LDSCTL_OFF = RING_BYTES, MISC_OFF = LDSCTL_OFF + 320, LDS_BYTES = 147456;
constexpr int NPH = 12;
#ifndef MK_N_LAUNCHES
#define MK_N_LAUNCHES 1
#endif

__device__ __forceinline__ float wave_sum(float v) {
#pragma unroll
    for (int o = 1; o < 64; o <<= 1) v += __shfl_xor(v, o);
    return v;
}
__device__ __forceinline__ float bflo(unsigned u) { return __uint_as_float(u << 16); }
__device__ __forceinline__ float bfhi(unsigned u) { return __uint_as_float(u & 0xffff0000u); }
__device__ __forceinline__ float rcp_f(float x) { return __builtin_amdgcn_rcpf(x); }
__device__ __forceinline__ float sigm_f(float x) { return rcp_f(1.f + __expf(-x)); }
__device__ __forceinline__ float silu2_f(float x) { return x * sigm_f(x); }
__device__ __forceinline__ float gelu_f(float x) { return x * sigm_f(1.5957691216057308f * (x + 0.044715f * x * x * x)); }
__device__ __forceinline__ bf16x8 pack8(f32x4 a, f32x4 b) { v4u t; t.x = pg8::cvt_pk_bf16(a[0], a[1]); t.y = pg8::cvt_pk_bf16(a[2], a[3]); t.z = pg8::cvt_pk_bf16(b[0], b[1]); t.w = pg8::cvt_pk_bf16(b[2], b[3]); return __builtin_bit_cast(bf16x8, t); }
#define MFMA16(a, b, c) __builtin_amdgcn_mfma_f32_16x16x32_bf16((a), (b), (c), 0, 0, 0)

struct Args { const float* in[22]; float* out; unsigned char* ws; int ph_lo, ph_hi, use_cg, pad; };
struct Ctx { LAS unsigned char* lds; int tid, lane, wave, vcu, G; };

__device__ __forceinline__ void transpose_item(const float* W, int K, int N, bf16* WT, int kb, int n0, int drow0, LAS float* scr, int lane) {
    const int k0 = 64 * kb;
#pragma unroll 8
    for (int i = 0; i < 32; ++i) { const int kk = 2 * i + (lane >> 5); scr[kk * 33 + (lane & 31)] = W[(size_t)(k0 + kk) * N + n0 + (lane & 31)]; }
    LDS_WAIT(); asm volatile("" ::: "memory");
    const int c = lane & 7;
#pragma unroll
    for (int j = 0; j < 4; ++j) { const int n = (lane >> 3) + 8 * j; const LAS float* s = scr + (8 * c) * 33 + n;
        v4u o; o.x = pk2(s[0 * 33], s[1 * 33]); o.y = pk2(s[2 * 33], s[3 * 33]); o.z = pk2(s[4 * 33], s[5 * 33]); o.w = pk2(s[6 * 33], s[7 * 33]);
        *(v4u*)(WT + (size_t)(drow0 + n) * K + k0 + 8 * c) = o; }
    LDS_WAIT(); asm volatile("" ::: "memory");
}
__device__ __forceinline__ void phase_p0(const Args& a, const Ctx& C) {
    unsigned char* ws = a.ws;
    { bf16* SC = (bf16*)(ws + WS_SC); const float* cp = a.in[3]; const float* cs = a.in[4];
      for (int e = C.vcu * NTHR + C.tid; e < 144 * DM; e += C.G * NTHR) { const int r = e >> 10; float v = 0.f;
          if (r < NBP) v = silu2_f(cp[e]); else if (r < NSEQ) v = silu2_f(cs[e - NBP * DM]);
          SC[e] = (bf16)f2bf(v); } }
    LAS float* scr = (LAS float*)(C.lds + C.wave * 16384);
    const int gw = C.vcu * NWAVES + C.wave, NGW = C.G * NWAVES;
    constexpr int I_IN = 16 * 96, I_OUT = 16 * 32, I_G = 16 * 88, I_D = 44 * 32, NITEMS = I_IN + I_OUT + 2 * I_G + I_D;
    for (int it = gw; it < NITEMS; it += NGW) {
        int r = it;
        if (r < I_IN) { const int kb = r / 96, n0 = 32 * (r % 96); transpose_item(a.in[10], DM, NIN, (bf16*)(ws + WS_WIN), kb, n0, n0, scr, C.lane); continue; } r -= I_IN;
        if (r < I_OUT) { const int kb = r / 32, n0 = 32 * (r % 32); transpose_item(a.in[16], DM, DM, (bf16*)(ws + WS_WOUT), kb, n0, n0, scr, C.lane); continue; } r -= I_OUT;
        if (r < I_G) { const int kb = r / 88, n0 = 32 * (r % 88); transpose_item(a.in[19], DM, DFF, (bf16*)(ws + WS_WGU), kb, n0, 256 * (n0 >> 7) + (n0 & 127), scr, C.lane); continue; } r -= I_G;
        if (r < I_G) { const int kb = r / 88, n0 = 32 * (r % 88); transpose_item(a.in[20], DM, DFF, (bf16*)(ws + WS_WGU), kb, n0, 256 * (n0 >> 7) + 128 + (n0 & 127), scr, C.lane); continue; } r -= I_G;
        { const int kb = r / 32, n0 = 32 * (r % 32); transpose_item(a.in[21], DFF, DM, (bf16*)(ws + WS_WDN), kb, n0, n0, scr, C.lane); }
    }
}
__device__ __forceinline__ void phase_mod(const Args& a, const Ctx& C) {
    const bf16* SC = (const bf16*)(a.ws + WS_SC); const float* wada = a.in[6]; const float* bada = a.in[7]; float* MOD = (float*)(a.ws + WS_MOD);
    const int i = C.lane & 15, kq = C.lane >> 4;
    LAS f32x4* RED = (LAS f32x4*)C.lds;
    for (int strip = C.vcu; strip < NMOD / 16; strip += C.G) {
        const int n0 = strip * 16;
        f32x4 acc[9];
#pragma unroll
        for (int rb = 0; rb < 9; ++rb) acc[rb] = (f32x4){0.f, 0.f, 0.f, 0.f};
#pragma unroll 2
        for (int kk = 0; kk < 4; ++kk) {
            const int k0 = (C.wave * 4 + kk) * 32 + kq * 8;
            const float* wp = wada + (size_t)k0 * NMOD + n0 + i;
            f32x4 w0, w1;
            w0[0] = wp[0]; w0[1] = wp[(size_t)NMOD]; w0[2] = wp[(size_t)2 * NMOD]; w0[3] = wp[(size_t)3 * NMOD];
            w1[0] = wp[(size_t)4 * NMOD]; w1[1] = wp[(size_t)5 * NMOD]; w1[2] = wp[(size_t)6 * NMOD]; w1[3] = wp[(size_t)7 * NMOD];
            const bf16x8 af = pack8(w0, w1);
#pragma unroll
            for (int rb = 0; rb < 9; ++rb) { const bf16x8 bfr = *(const bf16x8*)(SC + (size_t)(rb * 16 + i) * DM + k0); acc[rb] = MFMA16(af, bfr, acc[rb]); }
        }
#pragma unroll
        for (int rb = 0; rb < 9; ++rb) RED[(C.wave * 9 + rb) * 64 + C.lane] = acc[rb];
        __syncthreads();
        for (int slot = C.tid; slot < 9 * 64; slot += NTHR) { const int rb = slot >> 6, ln = slot & 63, r = rb * 16 + (ln & 15), n = n0 + (ln >> 4) * 4;
            f32x4 sum = *(const f32x4*)(bada + n);
#pragma unroll
            for (int ww = 0; ww < 8; ++ww) sum += RED[(ww * 9 + rb) * 64 + ln];
            if (r < NSEQ) *(f32x4*)(MOD + (size_t)r * NMOD + n) = sum; }
        __syncthreads();
    }
}
__device__ __forceinline__ const float* xrow_ptr(const Args& a, int m) { return m < MP ? a.in[0] + (size_t)m * DM : a.in[1] + (size_t)(m - MP) * DM; }
__device__ __forceinline__ int seq_of(int m) { return m < MP ? (m >> 11) : NBP + ((m - MP) >> 3); }
__device__ __forceinline__ void store4bf(bf16* p, f32x4 v) { v2u o; o.x = pg8::cvt_pk_bf16(v[0], v[1]); o.y = pg8::cvt_pk_bf16(v[2], v[3]); *(v2u*)p = o; }
__device__ __forceinline__ f32x4 load4bf(const bf16* p) { const v2u w = *(const v2u*)p; return (f32x4){bflo(w.x), bfhi(w.x), bflo(w.y), bfhi(w.y)}; }
__device__ __forceinline__ void phase_p1(const Args& a, const Ctx& C) {
    const float* MOD = (const float*)(a.ws + WS_MOD); bf16* H = (bf16*)(a.ws + WS_H); const float* npm = a.in[8];
    for (int m = C.vcu * NWAVES + C.wave; m < MT; m += C.G * NWAVES) {
        const float* xr = xrow_ptr(a, m); const float* md = MOD + (size_t)seq_of(m) * NMOD;
        f32x4 v[4]; float ss = 0.f;
#pragma unroll
        for (int j = 0; j < 4; ++j) { v[j] = *(const f32x4*)(xr + 4 * C.lane + 256 * j); ss += (v[j][0] * v[j][0] + v[j][1] * v[j][1]) + (v[j][2] * v[j][2] + v[j][3] * v[j][3]); }
        const float rs = rsqrtf(wave_sum(ss) * (1.f / DM) + EPS);
#pragma unroll
        for (int j = 0; j < 4; ++j) { const int c = 4 * C.lane + 256 * j;
            const f32x4 g = *(const f32x4*)(npm + c), sh = *(const f32x4*)(md + c), sc = *(const f32x4*)(md + DM + c);
            store4bf(H + (size_t)m * DM + c, v[j] * rs * g * (sc + 1.f) + sh); }
    }
}
__device__ __forceinline__ void phase_p5(const Args& a, const Ctx& C) {
    const float* MOD = (const float*)(a.ws + WS_MOD); bf16* H = (bf16*)(a.ws + WS_H); const bf16* MB = (const bf16*)(a.ws + WS_MB);
    const float* npost = a.in[9]; const float* npre = a.in[17];
    for (int m = C.vcu * NWAVES + C.wave; m < MT; m += C.G * NWAVES) {
        const float* xr = xrow_ptr(a, m); const float* md = MOD + (size_t)seq_of(m) * NMOD;
        f32x4 mv[4]; float ss = 0.f;
#pragma unroll
        for (int j = 0; j < 4; ++j) { mv[j] = load4bf(MB + (size_t)m * DM + 4 * C.lane + 256 * j); ss += (mv[j][0] * mv[j][0] + mv[j][1] * mv[j][1]) + (mv[j][2] * mv[j][2] + mv[j][3] * mv[j][3]); }
        const float rs = rsqrtf(wave_sum(ss) * (1.f / DM) + EPS);
        f32x4 x1[4]; float ss2 = 0.f;
#pragma unroll
        for (int j = 0; j < 4; ++j) { const int c = 4 * C.lane + 256 * j;
            const f32x4 xv = *(const f32x4*)(xr + c), g = *(const f32x4*)(npost + c), g1 = *(const f32x4*)(md + 2 * DM + c);
            x1[j] = xv + g1 * (mv[j] * rs * g);
            *(f32x4*)(a.out + O_Y + (size_t)m * DM + c) = x1[j];
            ss2 += (x1[j][0] * x1[j][0] + x1[j][1] * x1[j][1]) + (x1[j][2] * x1[j][2] + x1[j][3] * x1[j][3]); }
        const float rs2 = rsqrtf(wave_sum(ss2) * (1.f / DM) + EPS);
#pragma unroll
        for (int j = 0; j < 4; ++j) { const int c = 4 * C.lane + 256 * j;
            const f32x4 g = *(const f32x4*)(npre + c), sh = *(const f32x4*)(md + 3 * DM + c), sc = *(const f32x4*)(md + 4 * DM + c);
            store4bf(H + (size_t)m * DM + c, x1[j] * rs2 * g * (sc + 1.f) + sh); }
    }
}
__device__ __forceinline__ void phase_p8(const Args& a, const Ctx& C) {
    const float* MOD = (const float*)(a.ws + WS_MOD); const bf16* FB = (const bf16*)(a.ws + WS_FB); const float* npf = a.in[18];
    for (int m = C.vcu * NWAVES + C.wave; m < MT; m += C.G * NWAVES) {
        const float* md = MOD + (size_t)seq_of(m) * NMOD;
        f32x4 fv[4]; float ss = 0.f;
#pragma unroll
        for (int j = 0; j < 4; ++j) { fv[j] = load4bf(FB + (size_t)m * DM + 4 * C.lane + 256 * j); ss += (fv[j][0] * fv[j][0] + fv[j][1] * fv[j][1]) + (fv[j][2] * fv[j][2] + fv[j][3] * fv[j][3]); }
        const float rs = rsqrtf(wave_sum(ss) * (1.f / DM) + EPS);
#pragma unroll
        for (int j = 0; j < 4; ++j) { const int c = 4 * C.lane + 256 * j; float* op = a.out + O_Y + (size_t)m * DM + c;
            const f32x4 x1 = *(const f32x4*)op, g = *(const f32x4*)(npf + c), g2 = *(const f32x4*)(md + 5 * DM + c);
            *(f32x4*)op = x1 + g2 * (fv[j] * rs * g); }
    }
}
constexpr int A_LF = 0, A_LFS = 132, A_PT = 33792, A_QD = 35840, A_KD = 53248, A_KET = 70656, A_VT = 89088, A_PP = 107520, A_LB = 116736;
__device__ __forceinline__ void unpack16(const v4u a, const v4u b, float (&z)[16]) {
    z[0] = bflo(a.x); z[1] = bfhi(a.x); z[2] = bflo(a.y); z[3] = bfhi(a.y); z[4] = bflo(a.z); z[5] = bfhi(a.z); z[6] = bflo(a.w); z[7] = bfhi(a.w);
    z[8] = bflo(b.x); z[9] = bfhi(b.x); z[10] = bflo(b.y); z[11] = bfhi(b.y); z[12] = bflo(b.z); z[13] = bfhi(b.z); z[14] = bflo(b.w); z[15] = bfhi(b.w);
}
__device__ __forceinline__ void hgrn_pass_a(const Args& a, const Ctx& C, int item) {
    const bf16* Z = (const bf16*)(a.ws + WS_Z); float* DS = (float*)(a.ws + WS_DS); float* DEC = (float*)(a.ws + WS_DEC);
    bf16* QDG = (bf16*)((unsigned char*)a.out + OUT_QD); float* OI = (float*)((unsigned char*)a.out + OUT_OI);
    const float* lbl = a.in[5];
    const int bh = item >> 5, n = item & 31, b = bh >> 2, h = bh & 3, tok0 = b * SEQ + n * 64;
    LAS unsigned char* lds = C.lds; LAS float* LF = (LAS float*)(lds + A_LF); LAS float* PT = (LAS float*)(lds + A_PT); LAS float* LB = (LAS float*)(lds + A_LB);
    const int tid = C.tid, w = C.wave, i = C.lane & 15, kq = C.lane >> 4;
    if (tid < 128) { const float l0 = lbl[h * 128 + tid], l1 = lbl[512 + h * 128 + tid]; LB[tid] = rcp_f(1.f + __expf(l1 - l0)); }
    __syncthreads();
    const int t = tid >> 3, c0 = (tid & 7) * 16;
    const bf16* zrow = Z + (size_t)(tok0 + t) * NIN + h * 128 + c0;
    float kk[16];
    const v4u f0 = *(const v4u*)(zrow + ZF), f1 = *(const v4u*)(zrow + ZF + 8);
    const v4u q0 = *(const v4u*)(zrow + ZQ), q1 = *(const v4u*)(zrow + ZQ + 8), i0 = *(const v4u*)(zrow + ZI), i1 = *(const v4u*)(zrow + ZI + 8);
    { float z[16]; unpack16(f0, f1, z);
#pragma unroll
      for (int j = 0; j < 16; ++j) { const float lb = LB[c0 + j], sg = sigm_f(z[j]); const float f = lb + (1.f - lb) * sg; kk[j] = (1.f - lb) * (1.f - sg); LF[t * A_LFS + c0 + j] = __logf(f); } }
    __syncthreads();
    { const int k = tid & 127, part = tid >> 7; float run = 0.f;
#pragma unroll
      for (int r = 0; r < 16; ++r) { LAS float* p = LF + (part * 16 + r) * A_LFS + k; run += *p; *p = run; }
      PT[part * 128 + k] = run; }
    __syncthreads();
    { const int k = tid & 127, part = tid >> 7;
      const float off = (part > 0 ? PT[k] : 0.f) + (part > 1 ? PT[128 + k] : 0.f) + (part > 2 ? PT[256 + k] : 0.f);
      if (part > 0) {
#pragma unroll
          for (int r = 0; r < 16; ++r) LF[(part * 16 + r) * A_LFS + k] += off; } }
    __syncthreads();
    { float q[16]; unpack16(q0, q1, q);
      float qd[16], kd[16], ke[16];
#pragma unroll
      for (int j = 0; j < 16; ++j) { const float bb = LF[t * A_LFS + c0 + j], bl = LF[63 * A_LFS + c0 + j];
          qd[j] = q[j] * __expf(bb); kd[j] = kk[j] * __expf(-bb); ke[j] = kk[j] * __expf(bl - bb);
          if (t == 63) DEC[(size_t)item * 128 + c0 + j] = __expf(bl); }
      v4u o0, o1;
      o0.x = pg8::cvt_pk_bf16(qd[0], qd[1]); o0.y = pg8::cvt_pk_bf16(qd[2], qd[3]); o0.z = pg8::cvt_pk_bf16(qd[4], qd[5]); o0.w = pg8::cvt_pk_bf16(qd[6], qd[7]);
      o1.x = pg8::cvt_pk_bf16(qd[8], qd[9]); o1.y = pg8::cvt_pk_bf16(qd[10], qd[11]); o1.z = pg8::cvt_pk_bf16(qd[12], qd[13]); o1.w = pg8::cvt_pk_bf16(qd[14], qd[15]);
      *(LAS v4u*)(lds + A_QD + t * 272 + c0 * 2) = o0; *(LAS v4u*)(lds + A_QD + t * 272 + c0 * 2 + 16) = o1;
      bf16* qg = QDG + (size_t)(tok0 + t) * 512 + h * 128 + c0; *(v4u*)qg = o0; *(v4u*)(qg + 8) = o1;
      o0.x = pg8::cvt_pk_bf16(kd[0], kd[1]); o0.y = pg8::cvt_pk_bf16(kd[2], kd[3]); o0.z = pg8::cvt_pk_bf16(kd[4], kd[5]); o0.w = pg8::cvt_pk_bf16(kd[6], kd[7]);
      o1.x = pg8::cvt_pk_bf16(kd[8], kd[9]); o1.y = pg8::cvt_pk_bf16(kd[10], kd[11]); o1.z = pg8::cvt_pk_bf16(kd[12], kd[13]); o1.w = pg8::cvt_pk_bf16(kd[14], kd[15]);
      *(LAS v4u*)(lds + A_KD + t * 272 + c0 * 2) = o0; *(LAS v4u*)(lds + A_KD + t * 272 + c0 * 2 + 16) = o1;
      const unsigned vi[8] = {i0.x, i0.y, i0.z, i0.w, i1.x, i1.y, i1.z, i1.w};
#pragma unroll
      for (int j = 0; j < 16; ++j) {
          *(LAS unsigned short*)(lds + A_KET + (c0 + j) * 144 + t * 2) = (unsigned short)f2bf(ke[j]);
          *(LAS unsigned short*)(lds + A_VT + (c0 + j) * 144 + t * 2) = (unsigned short)((j & 1) ? (vi[j >> 1] >> 16) : (vi[j >> 1] & 0xffffu)); } }
    __syncthreads();
    { const int tb = w >> 1;
#pragma unroll
      for (int e = 0; e < 2; ++e) { const int sb = 2 * (w & 1) + e; f32x4 acc = (f32x4){0.f, 0.f, 0.f, 0.f};
#pragma unroll
          for (int ks = 0; ks < 4; ++ks) { const bf16x8 A = *(const LAS bf16x8*)(lds + A_KD + (16 * sb + i) * 272 + (ks * 32 + kq * 8) * 2), B = *(const LAS bf16x8*)(lds + A_QD + (16 * tb + i) * 272 + (ks * 32 + kq * 8) * 2);
              acc = MFMA16(A, B, acc); }
          const int tt = 16 * tb + i, s0 = 16 * sb + kq * 4;
          v2u o; o.x = pg8::cvt_pk_bf16(s0 <= tt ? acc[0] : 0.f, s0 + 1 <= tt ? acc[1] : 0.f); o.y = pg8::cvt_pk_bf16(s0 + 2 <= tt ? acc[2] : 0.f, s0 + 3 <= tt ? acc[3] : 0.f);
          *(LAS v2u*)(lds + A_PP + tt * 144 + s0 * 2) = o; } }
    { bf16x8 A2[2];
#pragma unroll
      for (int sc = 0; sc < 2; ++sc) A2[sc] = *(const LAS bf16x8*)(lds + A_KET + (16 * w + i) * 144 + (sc * 32 + kq * 8) * 2);
#pragma unroll
      for (int vb = 0; vb < 8; ++vb) { f32x4 acc = (f32x4){0.f, 0.f, 0.f, 0.f};
#pragma unroll
          for (int sc = 0; sc < 2; ++sc) { const bf16x8 B = *(const LAS bf16x8*)(lds + A_VT + (16 * vb + i) * 144 + (sc * 32 + kq * 8) * 2); acc = MFMA16(A2[sc], B, acc); }
          *(f32x4*)(DS + (size_t)item * 16384 + (16 * vb + i) * 128 + 16 * w + kq * 4) = acc; } }
    __syncthreads();
    { bf16x8 A3[2];
#pragma unroll
      for (int sc = 0; sc < 2; ++sc) A3[sc] = *(const LAS bf16x8*)(lds + A_VT + (16 * w + i) * 144 + (sc * 32 + kq * 8) * 2);
#pragma unroll
      for (int tb = 0; tb < 4; ++tb) { f32x4 acc = (f32x4){0.f, 0.f, 0.f, 0.f};
#pragma unroll
          for (int sc = 0; sc < 2; ++sc) { const bf16x8 B = *(const LAS bf16x8*)(lds + A_PP + (16 * tb + i) * 144 + (sc * 32 + kq * 8) * 2); acc = MFMA16(A3[sc], B, acc); }
          *(f32x4*)(OI + (size_t)(tok0 + 16 * tb + i) * 512 + h * 128 + 16 * w + kq * 4) = acc; } }
    __syncthreads();
}
__device__ __forceinline__ void hgrn_sample(const Args& a, const Ctx& C, int item) {
    const bf16* Z = (const bf16*)(a.ws + WS_Z); bf16* H = (bf16*)(a.ws + WS_H); const float* lbl = a.in[5]; const float* gnw = a.in[11];
    const int b = item >> 2, h = item & 3, m0 = MP + b * DSEQ, tid = C.tid;
    LAS float* F8 = (LAS float*)C.lds; LAS float* K8 = F8 + 1024; LAS float* Q8 = F8 + 2048; LAS float* V8 = F8 + 3072; LAS float* OP = F8 + 4096;
    const int v = tid & 127, kp = tid >> 7;
    const size_t sbase = ((size_t)item * 128 + kp * 32) * 128 + v;
    const float* s0 = a.in[2] + sbase;
    float S[32];
#pragma unroll
    for (int r = 0; r < 32; ++r) S[r] = s0[(size_t)r * 128];
    for (int idx = tid; idx < 1024; idx += NTHR) { const int t = idx >> 7, k = idx & 127; const bf16* zr = Z + (size_t)(m0 + t) * NIN + h * 128 + k;
        const float l0 = lbl[h * 128 + k], l1 = lbl[512 + h * 128 + k], lb = rcp_f(1.f + __expf(l1 - l0));
        const float sg = sigm_f(bflo(zr[ZF])); F8[idx] = lb + (1.f - lb) * sg; K8[idx] = (1.f - lb) * (1.f - sg); Q8[idx] = bflo(zr[ZQ]); V8[idx] = bflo(zr[ZI]); }
    __syncthreads();
#pragma unroll 1
    for (int t = 0; t < DSEQ; ++t) { const float vt = V8[t * 128 + v]; float o = 0.f;
#pragma unroll
        for (int r4 = 0; r4 < 8; ++r4) { const f32x4 f = *(const LAS f32x4*)(F8 + t * 128 + kp * 32 + r4 * 4), kx = *(const LAS f32x4*)(K8 + t * 128 + kp * 32 + r4 * 4), qx = *(const LAS f32x4*)(Q8 + t * 128 + kp * 32 + r4 * 4);
#pragma unroll
            for (int e = 0; e < 4; ++e) { S[r4 * 4 + e] = f[e] * S[r4 * 4 + e] + kx[e] * vt; o += S[r4 * 4 + e] * qx[e]; } }
        OP[(t * 4 + kp) * 128 + v] = o; }
    float* so = a.out + O_SS + sbase;
#pragma unroll
    for (int r = 0; r < 32; ++r) so[(size_t)r * 128] = S[r];
    __syncthreads();
    { const int t = C.wave, l = C.lane;
      const float o0 = (OP[(t * 4 + 0) * 128 + l] + OP[(t * 4 + 1) * 128 + l]) + (OP[(t * 4 + 2) * 128 + l] + OP[(t * 4 + 3) * 128 + l]);
      const float o1 = (OP[(t * 4 + 0) * 128 + 64 + l] + OP[(t * 4 + 1) * 128 + 64 + l]) + (OP[(t * 4 + 2) * 128 + 64 + l] + OP[(t * 4 + 3) * 128 + 64 + l]);
      const float rs = rsqrtf(wave_sum(o0 * o0 + o1 * o1) * (1.f / 128.f) + EPS);
      const bf16* zg = Z + (size_t)(m0 + t) * NIN + ZG + h * 128; bf16* hp = H + (size_t)(m0 + t) * DM + h * 128;
      hp[l] = (bf16)f2bf(o0 * rs * gnw[l] * silu2_f(bflo(zg[l]))); hp[64 + l] = (bf16)f2bf(o1 * rs * gnw[64 + l] * silu2_f(bflo(zg[64 + l]))); }
    __syncthreads();
}
__device__ __forceinline__ void cmlp_prompt(const Args& a, const Ctx& C, int item) {
    const bf16* Z = (const bf16*)(a.ws + WS_Z); bf16* H = (bf16*)(a.ws + WS_H);
    const float* lng = a.in[12]; const float* lnb = a.in[13]; const float* wsp = a.in[14]; const float* bsp = a.in[15];
    const int g = item & 3, c = (item >> 2) & 15, b = item >> 6, tok0 = b * SEQ + c * 128;
    LAS unsigned char* lds = C.lds; const int tid = C.tid, w = C.wave, i = C.lane & 15, kq = C.lane >> 4;
    const int t = 16 * w + i, nks = (w >> 1) + 1;
    bf16x8 Bf[4]; v2u zuv[8]; float bs;
    { const float* wr = wsp + (size_t)g * 16384 + (size_t)t * 128 + kq * 8;
#pragma unroll
      for (int ks = 0; ks < 4; ++ks) { f32x4 b0 = (f32x4){0.f, 0.f, 0.f, 0.f}, b1 = b0;
          if (ks < nks) { b0 = *(const f32x4*)(wr + ks * 32); b1 = *(const f32x4*)(wr + ks * 32 + 4); }
          const int sb = ks * 32 + kq * 8;
#pragma unroll
          for (int e = 0; e < 4; ++e) { b0[e] = (sb + e <= t) ? b0[e] : 0.f; b1[e] = (sb + 4 + e <= t) ? b1[e] : 0.f; }
          Bf[ks] = pack8(b0, b1); }
      bs = bsp[g * 128 + t];
      const bf16* zu = Z + (size_t)(tok0 + t) * NIN + ZU + g * 128 + kq * 4;
#pragma unroll
      for (int db = 0; db < 8; ++db) zuv[db] = *(const v2u*)(zu + 16 * db); }
    { const int s = tid >> 2, part = tid & 3;
      const bf16* zr = Z + (size_t)(tok0 + s) * NIN + ZV + part * 128; float s1 = 0.f, s2 = 0.f;
#pragma unroll 4
      for (int q = 0; q < 16; ++q) { const v4u wv = *(const v4u*)(zr + q * 8); const unsigned u4[4] = {wv.x, wv.y, wv.z, wv.w};
#pragma unroll
          for (int e = 0; e < 4; ++e) { const float x0 = gelu_f(bflo(u4[e])), x1 = gelu_f(bfhi(u4[e])); s1 += x0 + x1; s2 += x0 * x0 + x1 * x1; } }
      s1 += __shfl_xor(s1, 1); s2 += __shfl_xor(s2, 1); s1 += __shfl_xor(s1, 2); s2 += __shfl_xor(s2, 2);
      const float mean = s1 * (1.f / 512.f), var = fmaxf(s2 * (1.f / 512.f) - mean * mean, 0.f), rstd = rsqrtf(var + EPS);
      const bf16* zr2 = Z + (size_t)(tok0 + s) * NIN + ZV + g * 128 + part * 32;
      float* vout = a.out + O_VP + ((size_t)(b * 128 + s)) * 512 + g * 128 + part * 32;
#pragma unroll
      for (int q = 0; q < 4; ++q) { const v4u wv = *(const v4u*)(zr2 + q * 8); const unsigned u4[4] = {wv.x, wv.y, wv.z, wv.w};
          const int d0 = part * 32 + q * 8; float vv[8];
#pragma unroll
          for (int e = 0; e < 4; ++e) { vv[2 * e] = gelu_f(bflo(u4[e])); vv[2 * e + 1] = gelu_f(bfhi(u4[e])); }
          const f32x4 ga = *(const f32x4*)(lng + g * 128 + d0), gb = *(const f32x4*)(lng + g * 128 + d0 + 4), ba = *(const f32x4*)(lnb + g * 128 + d0), bb = *(const f32x4*)(lnb + g * 128 + d0 + 4);
#pragma unroll
          for (int e = 0; e < 8; ++e) { vv[e] = (vv[e] - mean) * rstd * (e < 4 ? ga[e & 3] : gb[e & 3]) + (e < 4 ? ba[e & 3] : bb[e & 3]);
              *(LAS unsigned short*)(lds + (d0 + e) * 272 + s * 2) = (unsigned short)f2bf(vv[e]); }
          if (c == 15) { *(f32x4*)(vout + q * 8) = (f32x4){vv[0], vv[1], vv[2], vv[3]}; *(f32x4*)(vout + q * 8 + 4) = (f32x4){vv[4], vv[5], vv[6], vv[7]}; } } }
    __syncthreads();
    { f32x4 acc[8];
#pragma unroll
      for (int db = 0; db < 8; ++db) acc[db] = (f32x4){0.f, 0.f, 0.f, 0.f};
#pragma unroll
      for (int ks = 0; ks < 4; ++ks) if (ks < nks) {
#pragma unroll
          for (int db = 0; db < 8; ++db) { const bf16x8 A = *(const LAS bf16x8*)(lds + (16 * db + i) * 272 + (ks * 32 + kq * 8) * 2); acc[db] = MFMA16(A, Bf[ks], acc[db]); } }
      bf16* hp = H + (size_t)(tok0 + t) * DM + 512 + g * 128 + kq * 4;
#pragma unroll
      for (int db = 0; db < 8; ++db) { const f32x4 u = (f32x4){bflo(zuv[db].x), bfhi(zuv[db].x), bflo(zuv[db].y), bfhi(zuv[db].y)};
          store4bf(hp + 16 * db, (f32x4){gelu_f(u[0]) * (acc[db][0] + bs), gelu_f(u[1]) * (acc[db][1] + bs), gelu_f(u[2]) * (acc[db][2] + bs), gelu_f(u[3]) * (acc[db][3] + bs)}); } }
    __syncthreads();
}
__device__ __forceinline__ void cmlp_sample(const Args& a, const Ctx& C, int b) {
    const bf16* Z = (const bf16*)(a.ws + WS_Z); bf16* H = (bf16*)(a.ws + WS_H);
    const float* lng = a.in[12]; const float* lnb = a.in[13]; const float* wsp = a.in[14]; const float* bsp = a.in[15];
    const int m0 = MP + b * DSEQ, t = C.wave, c0 = C.lane * 8, g = c0 >> 7;
    LAS float* VS = (LAS float*)C.lds;
    const bf16* zr = Z + (size_t)(m0 + t) * NIN;
    const v4u zv = *(const v4u*)(zr + ZV + c0), zu = *(const v4u*)(zr + ZU + c0);
    const f32x4 lg0 = *(const f32x4*)(lng + c0), lg1 = *(const f32x4*)(lng + c0 + 4), lb0 = *(const f32x4*)(lnb + c0), lb1 = *(const f32x4*)(lnb + c0 + 4);
    float x[8] = {gelu_f(bflo(zv.x)), gelu_f(bfhi(zv.x)), gelu_f(bflo(zv.y)), gelu_f(bfhi(zv.y)), gelu_f(bflo(zv.z)), gelu_f(bfhi(zv.z)), gelu_f(bflo(zv.w)), gelu_f(bfhi(zv.w))};
    float s1 = 0.f, s2 = 0.f;
#pragma unroll
    for (int e = 0; e < 8; ++e) { s1 += x[e]; s2 += x[e] * x[e]; }
    s1 = wave_sum(s1); s2 = wave_sum(s2);
    const float mean = s1 * (1.f / 512.f), var = fmaxf(s2 * (1.f / 512.f) - mean * mean, 0.f), rstd = rsqrtf(var + EPS);
    f32x4 v0, v1;
#pragma unroll
    for (int e = 0; e < 4; ++e) { v0[e] = (x[e] - mean) * rstd * lg0[e] + lb0[e]; v1[e] = (x[4 + e] - mean) * rstd * lg1[e] + lb1[e]; }
    float* vo = a.out + O_VS + ((size_t)(b * DSEQ + t)) * 512 + c0; *(f32x4*)vo = v0; *(f32x4*)(vo + 4) = v1;
    *(LAS f32x4*)(VS + t * 512 + c0) = v0; *(LAS f32x4*)(VS + t * 512 + c0 + 4) = v1;
    __syncthreads();
    const float bs = bsp[g * 128 + t];
    f32x4 m0v = (f32x4){bs, bs, bs, bs}, m1v = m0v;
    const float* wrow = wsp + (size_t)g * 16384 + t * 128;
    for (int s = 0; s <= t; ++s) { const float w = wrow[s]; m0v += w * *(const LAS f32x4*)(VS + s * 512 + c0); m1v += w * *(const LAS f32x4*)(VS + s * 512 + c0 + 4); }
    v4u o;
    o.x = pg8::cvt_pk_bf16(gelu_f(bflo(zu.x)) * m0v[0], gelu_f(bfhi(zu.x)) * m0v[1]); o.y = pg8::cvt_pk_bf16(gelu_f(bflo(zu.y)) * m0v[2], gelu_f(bfhi(zu.y)) * m0v[3]);
    o.z = pg8::cvt_pk_bf16(gelu_f(bflo(zu.z)) * m1v[0], gelu_f(bfhi(zu.z)) * m1v[1]); o.w = pg8::cvt_pk_bf16(gelu_f(bflo(zu.w)) * m1v[2], gelu_f(bfhi(zu.w)) * m1v[3]);
    *(v4u*)(H + (size_t)(m0 + t) * DM + 512 + c0) = o;
    __syncthreads();
}
__device__ __forceinline__ void phase_m1(const Args& a, const Ctx& C) {
    constexpr int N_A = NBP * 4 * 32, N_S = NBS * 4, N_C = NBP * 16 * 4, N_D = NBS;
    for (int it = C.vcu; it < N_A + N_S + N_C + N_D; it += C.G) {
        if (it < N_A) hgrn_pass_a(a, C, it);
        else if (it < N_A + N_S) hgrn_sample(a, C, it - N_A);
        else if (it < N_A + N_S + N_C) cmlp_prompt(a, C, it - N_A - N_S);
        else cmlp_sample(a, C, it - N_A - N_S - N_C);
    }
}
__device__ __forceinline__ void phase_m2(const Args& a, const Ctx& C) {
    float* DS = (float*)(a.ws + WS_DS); const float* DEC = (const float*)(a.ws + WS_DEC);
    for (int e = C.vcu * NTHR + C.tid; e < 32 * 4096; e += C.G * NTHR) {
        const int bh = e >> 12, idx = e & 4095, v = idx >> 5, k4 = (idx & 31) * 4;
        f32x4 S = (f32x4){0.f, 0.f, 0.f, 0.f};
        float* p = DS + (size_t)bh * 32 * 16384 + v * 128 + k4; const float* dp = DEC + (size_t)bh * 32 * 128 + k4;
#pragma unroll 8
        for (int n = 0; n < 32; ++n) { const f32x4 ds = *(const f32x4*)(p + (size_t)n * 16384), dc = *(const f32x4*)(dp + n * 128);
            *(f32x4*)(p + (size_t)n * 16384) = S; S = dc * S + ds; }
        float* so = a.out + O_SP + (size_t)bh * 16384 + v;
#pragma unroll
        for (int c = 0; c < 4; ++c) so[(size_t)(k4 + c) * 128] = S[c];
    }
}
__device__ __forceinline__ void hgrn_pass_c(const Args& a, const Ctx& C, int item) {
    const bf16* Z = (const bf16*)(a.ws + WS_Z); bf16* H = (bf16*)(a.ws + WS_H); const float* DS = (const float*)(a.ws + WS_DS);
    const bf16* QDG = (const bf16*)((unsigned char*)a.out + OUT_QD); const float* OI = (const float*)((unsigned char*)a.out + OUT_OI); const float* gnw = a.in[11];
    const int bh = item >> 5, n = item & 31, b = bh >> 2, h = bh & 3, tok0 = b * SEQ + n * 64;
    const int w = C.wave, tb = w & 3, vh = w >> 2, i = C.lane & 15, kq = C.lane >> 4;
    f32x4 acc[4];
#pragma unroll
    for (int vb = 0; vb < 4; ++vb) acc[vb] = (f32x4){0.f, 0.f, 0.f, 0.f};
    const int t = 16 * tb + i;
    const bf16* qp = QDG + (size_t)(tok0 + t) * 512 + h * 128 + kq * 8;
    const float* sp = DS + (size_t)item * 16384 + (size_t)(64 * vh + i) * 128 + kq * 8;
    f32x4 oi[4], gwv[4]; v2u zgv[4];
#pragma unroll
    for (int vb = 0; vb < 4; ++vb) { const int v0 = 64 * vh + 16 * vb + kq * 4; oi[vb] = *(const f32x4*)(OI + (size_t)(tok0 + t) * 512 + h * 128 + v0);
        gwv[vb] = *(const f32x4*)(gnw + v0); zgv[vb] = *(const v2u*)(Z + (size_t)(tok0 + t) * NIN + ZG + h * 128 + v0); }
#pragma unroll
    for (int ks = 0; ks < 4; ++ks) { const bf16x8 B = *(const bf16x8*)(qp + ks * 32);
#pragma unroll
        for (int vb = 0; vb < 4; ++vb) { const float* p = sp + vb * 16 * 128 + ks * 32; const bf16x8 A = pack8(*(const f32x4*)p, *(const f32x4*)(p + 4)); acc[vb] = MFMA16(A, B, acc[vb]); } }
    float ss = 0.f; f32x4 o[4];
#pragma unroll
    for (int vb = 0; vb < 4; ++vb) { o[vb] = acc[vb] + oi[vb];
        ss += (o[vb][0] * o[vb][0] + o[vb][1] * o[vb][1]) + (o[vb][2] * o[vb][2] + o[vb][3] * o[vb][3]); }
    ss += __shfl_xor(ss, 16); ss += __shfl_xor(ss, 32);
    LAS float* SS = (LAS float*)C.lds;
    if (C.lane < 16) SS[w * 16 + C.lane] = ss;
    __syncthreads();
    const float rs = rsqrtf((SS[w * 16 + i] + SS[(w ^ 4) * 16 + i]) * (1.f / 128.f) + EPS);
#pragma unroll
    for (int vb = 0; vb < 4; ++vb) { const int v0 = 64 * vh + 16 * vb + kq * 4; const f32x4 gw = gwv[vb], zg = (f32x4){bflo(zgv[vb].x), bfhi(zgv[vb].x), bflo(zgv[vb].y), bfhi(zgv[vb].y)};
        store4bf(H + (size_t)(tok0 + t) * DM + h * 128 + v0, (f32x4){o[vb][0] * rs * gw[0] * silu2_f(zg[0]), o[vb][1] * rs * gw[1] * silu2_f(zg[1]), o[vb][2] * rs * gw[2] * silu2_f(zg[2]), o[vb][3] * rs * gw[3] * silu2_f(zg[3])}); }
    __syncthreads();
}
__device__ __forceinline__ void phase_m3(const Args& a, const Ctx& C) {
    for (int it = C.vcu; it < NBP * 4 * 32; it += C.G) hgrn_pass_c(a, C, it);
}

__global__ void __launch_bounds__(NTHR, 2) mk_fwd(Args args) {
    extern __shared__ __attribute__((aligned(16))) unsigned char lds_raw[];
    Ctx C;
    C.lds = (LAS unsigned char*)lds_raw;
    C.tid = threadIdx.x; C.lane = C.tid & 63; C.wave = __builtin_amdgcn_readfirstlane(C.tid >> 6);
    C.G = gridDim.x; { const int bx = blockIdx.x; C.vcu = (C.G % 8 == 0) ? (bx % 8) * (C.G / 8) + bx / 8 : bx; }
    volatile LAS unsigned* MISC = (volatile LAS unsigned*)(C.lds + MISC_OFF);
    for (int u = C.tid; u < (LDS_BYTES - LDSCTL_OFF) / 4; u += NTHR) ((LAS unsigned*)(C.lds + LDSCTL_OFF))[u] = 0u;
    __syncthreads();
    unsigned* barw = (unsigned*)(args.ws + WS_CTL) + CW_BAR;
    const int lo = args.ph_lo, hi = args.ph_hi;
    const bool multi = (hi - lo) > 1;
    XcdBarrier bar; bar.bar = barw; bar.x = 0; bar.st = nullptr;
    if (multi) bar = xcd_barrier_post(barw, MISC + 8);
    if (args.use_cg) cg::this_grid().sync();
#define IN(k) (lo <= (k) && (k) < hi)
#define SEAM(k) do { if (IN(k) && IN((k) + 1)) xcd_barrier(bar); } while (0)
    bf16* H = (bf16*)(args.ws + WS_H); bf16* Zb = (bf16*)(args.ws + WS_Z);
    if (IN(0)) { phase_p0(args, C); SEAM(0); }
    if (IN(1)) { phase_mod(args, C); SEAM(1); }
    if (IN(2)) { phase_p1(args, C); SEAM(2); }
    if (IN(3)) { pg8::Gemm g{H, (const bf16*)(args.ws + WS_WIN), MT, NIN, DM}; pg8::StaticOrder S; S.init(MT, NIN, C.G, (int)blockIdx.x);
        pg8::EpiStore E{Zb, NIN};
        pg8::gemm_phase<pg8::EpiStore, pg8::StaticOrder, true, true>(C.lds, g, S, E); SEAM(3); }
    if (IN(4)) { phase_m1(args, C); SEAM(4); }
    if (IN(5)) { phase_m2(args, C); SEAM(5); }
    if (IN(6)) { phase_m3(args, C); SEAM(6); }
    if (IN(7)) { pg8::Gemm g{H, (const bf16*)(args.ws + WS_WOUT), MT, DM, DM}; pg8::StaticOrder S; S.init(MT, DM, C.G, (int)blockIdx.x);
        pg8::EpiStore E{(bf16*)(args.ws + WS_MB), DM};
        pg8::gemm_phase<pg8::EpiStore, pg8::StaticOrder, true, true>(C.lds, g, S, E); SEAM(7); }
    if (IN(8)) { phase_p5(args, C); SEAM(8); }
    if (IN(9)) { pg8::Gemm g{H, (const bf16*)(args.ws + WS_WGU), MT, NGU, DM}; pg8::StaticOrder S; S.init(MT, NGU, C.G, (int)blockIdx.x);
        pg8::EpiSwiGLU E{(bf16*)(args.ws + WS_ACT), DFF};
        pg8::gemm_phase<pg8::EpiSwiGLU, pg8::StaticOrder, true, true>(C.lds, g, S, E); SEAM(9); }
    if (IN(10)) { pg8::Gemm g{(const bf16*)(args.ws + WS_ACT), (const bf16*)(args.ws + WS_WDN), MT, DM, DFF}; pg8::StaticOrder S; S.init(MT, DM, C.G, (int)blockIdx.x);
        pg8::EpiStore E{(bf16*)(args.ws + WS_FB), DM};
        pg8::gemm_phase<pg8::EpiStore, pg8::StaticOrder, true, true>(C.lds, g, S, E); SEAM(10); }
    if (IN(11)) { phase_p8(args, C); }
#undef IN
#undef SEAM
}

extern "C" void kernel_launch(void* const* d_in, const int* in_sizes, int n_in, void* d_out, int out_size, void* d_ws, size_t ws_size, hipStream_t stream) {
    static int grid = 0;
    if (grid == 0) {
        if (n_in != 22 || ws_size < WS_END) { fprintf(stderr, "kernel_launch: unexpected inputs (n_in %d, ws %zu)\n", n_in, ws_size); grid = -1; return; }
        int dev = 0, cus = 0, per_cu = 0;
        if (hipGetDevice(&dev) != hipSuccess || hipDeviceGetAttribute(&cus, hipDeviceAttributeMultiprocessorCount, dev) != hipSuccess) { grid = -1; return; }
        if (hipFuncSetAttribute((const void*)mk_fwd, hipFuncAttributeMaxDynamicSharedMemorySize, LDS_BYTES) != hipSuccess) { fprintf(stderr, "kernel_launch: hipFuncSetAttribute failed\n"); grid = -1; return; }
        if (hipOccupancyMaxActiveBlocksPerMultiprocessor(&per_cu, (const void*)mk_fwd, NTHR, LDS_BYTES) != hipSuccess || per_cu < 1) { fprintf(stderr, "kernel_launch: occupancy query says %d\n", per_cu); per_cu = 1; }
        (void)hipGetLastError();
        grid = cus;
    }
    if (grid < 0) return;
    (void)hipMemsetAsync((char*)d_ws + WS_CTL, 0, CTL_ZERO_BYTES, stream);
    Args a{};
    for (int i = 0; i < 22; ++i) a.in[i] = (const float*)d_in[i];
    a.out = (float*)d_out; a.ws = (unsigned char*)d_ws; a.use_cg = 0; a.pad = 0;
#if MK_N_LAUNCHES == 1
    a.ph_lo = 0; a.ph_hi = NPH;
    void* kargs[] = {&a};
    hipError_t e = hipLaunchCooperativeKernel((const void*)mk_fwd, dim3(grid), dim3(NTHR), kargs, LDS_BYTES, stream);
    if (e != hipSuccess) fprintf(stderr, "kernel_launch: cooperative launch failed: %s (grid %d)\n", hipGetErrorString(e), grid);
#else
    for (int p = 0; p < NPH; ++p) { a.ph_lo = p; a.ph_hi = p + 1; hipLaunchKernelGGL(mk_fwd, dim3(grid), dim3(NTHR), LDS_BYTES, stream, a); }
#endif
}
```

```cpp
#define MK_N_LAUNCHES 1
#include <hip/hip_runtime.h>
#include <hip/hip_cooperative_groups.h>
#include <cstdio>
#include <cstdint>
namespace pg8 {
#define PG8_LAS __attribute__((address_space(3)))
typedef unsigned short bf16_t;
typedef short bf16x8 __attribute__((ext_vector_type(8)));
typedef float f32x4 __attribute__((ext_vector_type(4)));
typedef unsigned u32x4 __attribute__((ext_vector_type(4)));
constexpr int BM = 256, BK = 64, HALF = 128, HTB = HALF * BK * 2  , STAGE_BYTES = 8 * HTB, NXCD = 8, WGM = 8;

__host__ __device__ __forceinline__ int lds_byte(int r, int c) { const int st = (r >> 4) * 2 + (c >> 5), rr = r & 15, cc = c & 31, ob = rr * 64 + cc * 2; return st * 1024 + (ob ^ (((ob >> 9) & 1) << 5)); }
__host__ __device__ __forceinline__ void stage_rc(int b, int& R, int& C) { const int st = b / 1024, sb = b % 1024, swz = sb ^ (((sb >> 9) & 1) << 5); R = (st >> 1) * 16 + swz / 64; C = (st & 1) * 32 + (swz % 64) / 2; }
__host__ __device__ __forceinline__ int perm32(int rho) { const int n = rho >> 4, i = rho & 15; return 8 * (i >> 2) + 4 * n + (i & 3); }

struct Unit { int pm, pn, kt0, nt, part; };
struct Gemm { const bf16_t* A; const bf16_t* Bt; int M, N, K; };

struct StaticOrder {
    int nM, nN, nwg, G, c;
    int ntf;
    __host__ __device__ void init(int M, int N, int K, int G_, int c_) { nM = M / BM; nN = N / BM; nwg = nM * nN; G = G_; c = c_; ntf = K / BK; }
    __host__ __device__ bool next(int i, Unit& u) const {
        const long L = (long)i * G + c; if (L >= nwg) return false;
        int wgid = (int)L; { const int q = nwg / NXCD, r = nwg % NXCD, xcd = wgid % NXCD, off = wgid / NXCD; wgid = (xcd < r ? xcd * (q + 1) : r * (q + 1) + (xcd - r) * q) + off; }
        const int nig = WGM * nN, gid = wgid / nig, fm = gid * WGM, gsz = (nM - fm) < WGM ? (nM - fm) : WGM;
        u.pm = fm + ((wgid % nig) % gsz); u.pn = (wgid % nig) / gsz; u.kt0 = 0; u.nt = ntf; u.part = -1; return true;
    }
    __device__ __forceinline__ void a_ready(const Unit&) const {}
    __device__ __forceinline__ void done(const Unit&) const {}
};
struct SplitOrder {
    StaticOrder full; int nMf, nMr, nN, KS, ntp, nfull, npart;
    __host__ __device__ void init(int Mfull, int Mrest, int N, int K, int ntp_, int G_, int c_) { full.init(Mfull, N, K, G_, c_); nMf = Mfull / BM; nMr = Mrest / BM; nN = N / BM; ntp = ntp_; KS = (K / BK) / ntp_; nfull = nMf * nN; npart = nMr * nN * KS; }
    __host__ __device__ bool next(int i, Unit& u) const {
        const long L = (long)i * full.G + full.c;
        if (L < nfull) return full.next(i, u);
        const int Lp = (int)(L - nfull); if (Lp >= npart) return false;
        const int ks = Lp % KS, tile = Lp / KS; u.pm = nMf + tile % nMr; u.pn = tile / nMr; u.kt0 = ks * ntp; u.nt = ntp; u.part = ks; return true;
    }
    __device__ __forceinline__ void a_ready(const Unit&) const {}
    __device__ __forceinline__ void done(const Unit&) const {}
};

__device__ __forceinline__ unsigned cvt_pk_bf16(float lo, float hi) { unsigned r; asm volatile("v_cvt_pk_bf16_f32 %0, %1, %2" : "=v"(r) : "v"(lo), "v"(hi)); return r; }
struct EpiStore {
    static constexpr bool PERM = true, AFTER_DRAIN = false;
    bf16_t* O; int ldc; float* P; int prow0, prows;
    __device__ __forceinline__ void operator()(const f32x4 (&acc)[2][2][4][2], const Unit& u, int wr, int wc, int fr, int fq) const {
        const int row0 = u.pm * BM + wr * 64 + fr, col0 = u.pn * BM + wc * 32 + 8 * fq;
        if (u.part >= 0) {
            float* pb = P + ((size_t)u.part * prows + (row0 - prow0)) * ldc + col0;
#pragma unroll
            for (int ai = 0; ai < 2; ++ai)
#pragma unroll
                for (int m = 0; m < 4; ++m) { float* rowp = pb + (size_t)(ai * HALF + m * 16) * ldc;
#pragma unroll
                    for (int bj = 0; bj < 2; ++bj) { *(f32x4*)(rowp + bj * HALF) = acc[ai][bj][m][0]; *(f32x4*)(rowp + bj * HALF + 4) = acc[ai][bj][m][1]; } }
            return;
        }
#pragma unroll
        for (int ai = 0; ai < 2; ++ai)
#pragma unroll
            for (int m = 0; m < 4; ++m) { bf16_t* rowp = O + (size_t)(row0 + ai * HALF + m * 16) * ldc + col0;
#pragma unroll
                for (int bj = 0; bj < 2; ++bj) { const f32x4 v0 = acc[ai][bj][m][0], v1 = acc[ai][bj][m][1];
                    u32x4 w; w.x = cvt_pk_bf16(v0[0], v0[1]); w.y = cvt_pk_bf16(v0[2], v0[3]); w.z = cvt_pk_bf16(v1[0], v1[1]); w.w = cvt_pk_bf16(v1[2], v1[3]);
                    *(u32x4*)(rowp + bj * HALF) = w; } }
    }
};
__device__ __forceinline__ float silu_f(float x) { return x * __builtin_amdgcn_rcpf(1.f + __expf(-x)); }
struct EpiSwiGLU {
    static constexpr bool PERM = true, AFTER_DRAIN = false;
    bf16_t* O; int ldc;
    __device__ __forceinline__ void operator()(const f32x4 (&acc)[2][2][4][2], const Unit& u, int wr, int wc, int fr, int fq) const {
        const int row0 = u.pm * BM + wr * 64 + fr, col0 = u.pn * HALF + wc * 32 + 8 * fq;
#pragma unroll
        for (int ai = 0; ai < 2; ++ai)
#pragma unroll
            for (int m = 0; m < 4; ++m) { bf16_t* rowp = O + (size_t)(row0 + ai * HALF + m * 16) * ldc + col0;
                const f32x4 g0 = acc[ai][0][m][0], g1 = acc[ai][0][m][1], u0 = acc[ai][1][m][0], u1 = acc[ai][1][m][1];
                u32x4 w;
                w.x = cvt_pk_bf16(silu_f(g0[0]) * u0[0], silu_f(g0[1]) * u0[1]); w.y = cvt_pk_bf16(silu_f(g0[2]) * u0[2], silu_f(g0[3]) * u0[3]);
                w.z = cvt_pk_bf16(silu_f(g1[0]) * u1[0], silu_f(g1[1]) * u1[1]); w.w = cvt_pk_bf16(silu_f(g1[2]) * u1[2], silu_f(g1[3]) * u1[3]);
                *(u32x4*)rowp = w; }
    }
};
template <class Epi, class Sched, bool ALIGN_EPI = false, bool SP2 = false>
__device__ __forceinline__ void gemm_phase(PG8_LAS unsigned char* lds, const Gemm g, const Sched& S, const Epi& E) {
    const int tid = threadIdx.x, wid = __builtin_amdgcn_readfirstlane(tid >> 6), lane = tid & 63, wr = wid >> 2, wc = wid & 3, fr = lane & 15, fq = lane >> 4;
    const int K = g.K; int nt = K / BK;
    unsigned voffA[2], voffB[2];
#pragma unroll
    for (int i = 0; i < 2; ++i) { int R, C; stage_rc(tid * 16 + i * 8192, R, C); const int Rb = Epi::PERM ? ((R & ~31) + perm32(R & 31)) : R;
        voffA[i] = (unsigned)(R * K + C) * 2u; voffB[i] = (unsigned)(Rb * K + C) * 2u; }
    const size_t kstep = (size_t)(BK * 2);
    const size_t hstep = (size_t)HALF * K * 2;
    const size_t tstep = 2 * hstep;
    const unsigned ldsw = (unsigned)wid * 1024u;
    const int aoff = lds_byte(wr * 64 + fr, fq * 8), boff = lds_byte(wc * 32 + fr, fq * 8);
#define PG8_SA(b, h) (((b) * 2 + (h)) * HTB)
#define PG8_SB(b, h) ((4 + (b) * 2 + (h)) * HTB)
#define PG8_STAGE(bufoff, gbase, voff) do { _Pragma("unroll") for (int _i = 0; _i < 2; ++_i) \
        __builtin_amdgcn_global_load_lds((const unsigned*)((const char*)(gbase) + (voff)[_i]), (PG8_LAS unsigned*)(lds + (bufoff) + ldsw + _i * 8192), 16, 0, 0); } while (0)
#define PG8_LDA(dst, b, h) do { _Pragma("unroll") for (int m = 0; m < 4; ++m) _Pragma("unroll") for (int k = 0; k < 2; ++k) dst[m][k] = *(const PG8_LAS bf16x8*)(lds + PG8_SA(b, h) + aoff + m * 2048 + k * 1024); } while (0)
#define PG8_LDB(dst, b, h) do { _Pragma("unroll") for (int n = 0; n < 2; ++n) _Pragma("unroll") for (int k = 0; k < 2; ++k) dst[n][k] = *(const PG8_LAS bf16x8*)(lds + PG8_SB(b, h) + boff + n * 2048 + k * 1024); } while (0)
#define PG8_MMA(ai, bj, At, Bt) do { __builtin_amdgcn_s_setprio(1); _Pragma("unroll") for (int m = 0; m < 4; ++m) _Pragma("unroll") for (int n = 0; n < 2; ++n) _Pragma("unroll") for (int k = 0; k < 2; ++k) \
        acc[ai][bj][m][n] = __builtin_amdgcn_mfma_f32_16x16x32_bf16(Bt[n][k], At[m][k], acc[ai][bj][m][n], 0, 0, 0); __builtin_amdgcn_s_setprio(0); } while (0)
#define PG8_WAIT_V(n) asm volatile("s_waitcnt vmcnt(" #n ")" ::: "memory")
#define PG8_WAIT_L(n) asm volatile("s_waitcnt lgkmcnt(" #n ")" ::: "memory")
#define PG8_BAR __builtin_amdgcn_s_barrier()
#define PG8_SCHED __builtin_amdgcn_sched_barrier(0)
    Unit cur, nxt; int ui = 0;
    if (!S.next(0, cur)) return;
    f32x4 acc[2][2][4][2];
#pragma unroll
    for (int a = 0; a < 2; ++a)
#pragma unroll
        for (int b = 0; b < 2; ++b)
#pragma unroll
            for (int m = 0; m < 4; ++m)
#pragma unroll
                for (int n = 0; n < 2; ++n) acc[a][b][m][n] = (f32x4){0.f, 0.f, 0.f, 0.f};
    bf16x8 At[4][2], B0[2][2], B1[2][2];
    nt = cur.nt;
    const char* cA = (const char*)g.A + (size_t)cur.pm * tstep + (size_t)cur.kt0 * kstep; const char* cB = (const char*)g.Bt + (size_t)cur.pn * tstep + (size_t)cur.kt0 * kstep;
    S.a_ready(cur);
    if constexpr (SP2) {
        PG8_STAGE(PG8_SB(0, 0), cB, voffB); PG8_STAGE(PG8_SB(0, 1), cB + hstep, voffB); PG8_STAGE(PG8_SA(0, 0), cA, voffA); PG8_STAGE(PG8_SA(0, 1), cA + hstep, voffA);
        if (wr == 1) PG8_BAR;
        PG8_WAIT_V(2); PG8_BAR;
        PG8_STAGE(PG8_SB(1, 0), cB + kstep, voffB); PG8_STAGE(PG8_SA(1, 0), cA + kstep, voffA); PG8_STAGE(PG8_SB(1, 1), cB + hstep + kstep, voffB);
        PG8_WAIT_V(6); PG8_BAR;
    } else {
        PG8_STAGE(PG8_SB(0, 0), cB, voffB); PG8_STAGE(PG8_SA(0, 0), cA, voffA); PG8_STAGE(PG8_SB(0, 1), cB + hstep, voffB); PG8_STAGE(PG8_SA(0, 1), cA + hstep, voffA);
        if (wr == 1) PG8_BAR;
        PG8_WAIT_V(4); PG8_BAR;
        PG8_STAGE(PG8_SB(1, 0), cB + kstep, voffB); PG8_STAGE(PG8_SA(1, 0), cA + kstep, voffA); PG8_STAGE(PG8_SB(1, 1), cB + hstep + kstep, voffB);
        PG8_WAIT_V(6); PG8_BAR;
    }
    for (;;) {
        const bool has_next = S.next(ui + 1, nxt);
        const char* nA = has_next ? (const char*)g.A + (size_t)nxt.pm * tstep + (size_t)nxt.kt0 * kstep : cA; const char* nB = has_next ? (const char*)g.Bt + (size_t)nxt.pn * tstep + (size_t)nxt.kt0 * kstep : cB;
        for (int t = 0; t < nt; t += 2) {
            const bool last = (t == nt - 2);
            const char* a1 = cA + (size_t)(t + 1) * kstep;
            const char* a2 = last ? nA : cA + (size_t)(t + 2) * kstep; const char* b2 = last ? nB : cB + (size_t)(t + 2) * kstep;
            const char* a3 = a2 + kstep; const char* b3 = b2 + kstep;
            if (last && has_next) S.a_ready(nxt);
            if constexpr (SP2) {
            PG8_LDB(B0, 0, 0); PG8_LDB(B1, 0, 1); PG8_SCHED; PG8_LDA(At, 0, 0); PG8_STAGE(PG8_SA(1, 1), a1 + hstep, voffA);
            PG8_WAIT_V(8); PG8_WAIT_L(0); PG8_BAR; PG8_MMA(0, 0, At, B0); PG8_MMA(0, 1, At, B1); PG8_BAR; PG8_SCHED;
            PG8_LDA(At, 0, 1); PG8_STAGE(PG8_SB(0, 0), b2, voffB); PG8_STAGE(PG8_SB(0, 1), b2 + hstep, voffB); PG8_STAGE(PG8_SA(0, 0), a2, voffA);
            PG8_WAIT_V(8); PG8_WAIT_L(0); PG8_BAR; PG8_MMA(1, 0, At, B0); PG8_MMA(1, 1, At, B1); PG8_BAR; PG8_SCHED;
            PG8_LDB(B0, 1, 0); PG8_LDB(B1, 1, 1); PG8_SCHED; PG8_LDA(At, 1, 0); PG8_STAGE(PG8_SA(0, 1), a2 + hstep, voffA);
            PG8_WAIT_V(8); PG8_WAIT_L(0); PG8_BAR; PG8_MMA(0, 0, At, B0); PG8_MMA(0, 1, At, B1); PG8_BAR; PG8_SCHED;
            PG8_LDA(At, 1, 1); PG8_STAGE(PG8_SB(1, 0), b3, voffB); PG8_STAGE(PG8_SB(1, 1), b3 + hstep, voffB); PG8_STAGE(PG8_SA(1, 0), a3, voffA);
            PG8_WAIT_V(8); PG8_WAIT_L(0); PG8_BAR; PG8_MMA(1, 0, At, B0); PG8_MMA(1, 1, At, B1); PG8_BAR; PG8_SCHED;
            } else {
            PG8_LDB(B0, 0, 0); PG8_SCHED; PG8_LDA(At, 0, 0); PG8_STAGE(PG8_SA(1, 1), a1 + hstep, voffA);
            PG8_WAIT_L(8); PG8_BAR; PG8_WAIT_L(0); PG8_MMA(0, 0, At, B0); PG8_BAR; PG8_SCHED;
            PG8_LDB(B1, 0, 1); PG8_STAGE(PG8_SB(0, 0), b2, voffB);
            PG8_BAR; PG8_WAIT_L(0); PG8_MMA(0, 1, At, B1); PG8_BAR;
            PG8_LDA(At, 0, 1); PG8_STAGE(PG8_SA(0, 0), a2, voffA);
            PG8_BAR; PG8_WAIT_L(0); PG8_MMA(1, 0, At, B0); PG8_BAR; PG8_SCHED;
            PG8_STAGE(PG8_SB(0, 1), b2 + hstep, voffB);
            PG8_WAIT_V(6); PG8_BAR; PG8_MMA(1, 1, At, B1); PG8_BAR;
            PG8_LDB(B0, 1, 0); PG8_SCHED; PG8_LDA(At, 1, 0); PG8_STAGE(PG8_SA(0, 1), a2 + hstep, voffA);
            PG8_WAIT_L(8); PG8_BAR; PG8_WAIT_L(0); PG8_MMA(0, 0, At, B0); PG8_BAR; PG8_SCHED;
            PG8_LDB(B1, 1, 1); PG8_STAGE(PG8_SB(1, 0), b3, voffB);
            PG8_BAR; PG8_WAIT_L(0); PG8_MMA(0, 1, At, B1); PG8_BAR;
            PG8_LDA(At, 1, 1); PG8_STAGE(PG8_SA(1, 0), a3, voffA);
            PG8_BAR; PG8_WAIT_L(0); PG8_MMA(1, 0, At, B0); PG8_BAR; PG8_SCHED;
            PG8_STAGE(PG8_SB(1, 1), b3 + hstep, voffB);
            PG8_WAIT_V(6); PG8_BAR; PG8_MMA(1, 1, At, B1); PG8_BAR;
            }
        }
        if constexpr (ALIGN_EPI) { if (wr == 0) PG8_BAR; }
        if constexpr (!Epi::AFTER_DRAIN) { E(acc, cur, wr, wc, fr, fq); S.done(cur); }
        if (!has_next) break;
#pragma unroll
        for (int a = 0; a < 2; ++a)
#pragma unroll
            for (int b = 0; b < 2; ++b)
#pragma unroll
                for (int m = 0; m < 4; ++m)
#pragma unroll
                    for (int n = 0; n < 2; ++n) acc[a][b][m][n] = (f32x4){0.f, 0.f, 0.f, 0.f};
        cur = nxt; cA = nA; cB = nB; ++ui; nt = cur.nt;
        if constexpr (ALIGN_EPI) { if (wr == 1) PG8_BAR; }
    }
    PG8_WAIT_V(0);
    if constexpr (!ALIGN_EPI) { if (wr == 0) PG8_BAR; }
    PG8_BAR;
    if constexpr (Epi::AFTER_DRAIN) { E.fused(acc, cur, wr, wc, fr, fq, lds, wid, lane); S.done(cur); }
#undef PG8_SA
#undef PG8_SB
#undef PG8_STAGE
#undef PG8_LDA
#undef PG8_LDB
#undef PG8_MMA
#undef PG8_WAIT_V
#undef PG8_WAIT_L
#undef PG8_BAR
#undef PG8_SCHED
}
}

#define GAS __attribute__((address_space(1)))
#define LAS __attribute__((address_space(3)))
typedef unsigned short bf16;
typedef unsigned v4u __attribute__((ext_vector_type(4)));
typedef unsigned v2u __attribute__((ext_vector_type(2)));
typedef float f32x4 __attribute__((ext_vector_type(4)));
typedef short bf16x8 __attribute__((ext_vector_type(8)));
typedef GAS unsigned gu32;
#define RLX_AGENT __ATOMIC_RELAXED, __HIP_MEMORY_SCOPE_AGENT
#define LDS_WAIT() asm volatile("s_waitcnt lgkmcnt(0)" ::: "memory")
#define VM_WAIT() asm volatile("s_waitcnt vmcnt(0)" ::: "memory")
__device__ __forceinline__ unsigned f2bf(float f) { unsigned u = __builtin_bit_cast(unsigned, f); return (u + 0x7fffu + ((u >> 16) & 1u)) >> 16; }
__device__ __forceinline__ unsigned pk2(float lo, float hi) { return f2bf(lo) | (f2bf(hi) << 16); }
#define XB_TMO      128
#define XB_XCNT(j)  (256  + 64 * (j))
#define XB_XSUB(j)  (1280 + 64 * (j))
#define XB_XGEN(j)  (2304 + 64 * (j))
#define XB_TOP      3328
#define XB_TOPGEN   3392
#define XCD_BAR_WORDS 3456
#define XB_SPIN_CAP (1u << 18)

__device__ __forceinline__ unsigned xb_ld(unsigned* p)              { return __hip_atomic_load(p, __ATOMIC_RELAXED, __HIP_MEMORY_SCOPE_AGENT); }
__device__ __forceinline__ unsigned xb_add(unsigned* p, unsigned v) { return __hip_atomic_fetch_add(p, v, __ATOMIC_RELAXED, __HIP_MEMORY_SCOPE_AGENT); }
__device__ __forceinline__ unsigned xb_xcc_id() { return (unsigned)__builtin_amdgcn_s_getreg((3 << 11) | 20) & 0xFu; }
#define XB_SPIN(cond, bar) do { unsigned _sp = 0; while (cond) { __builtin_amdgcn_s_sleep(1); \
    if ((++_sp & 255u) == 0u) { if (xb_ld(&(bar)[XB_TMO])) break; if (_sp > XB_SPIN_CAP) { atomicAdd(&(bar)[XB_TMO], 1u); break; } } } } while (0)

struct XcdBarrier {
    unsigned* bar; unsigned x;
    volatile LAS unsigned* st;
};

__device__ __forceinline__ XcdBarrier xcd_barrier_post(unsigned* bar, volatile LAS unsigned* st) {
    XcdBarrier b; b.bar = bar; b.x = xb_xcc_id(); b.st = st;
    if (threadIdx.x == 0) (void)xb_add(&bar[XB_XCNT(b.x)], 1u);
    return b;
}
__device__ __forceinline__ void xcd_barrier_complete(unsigned* bar, unsigned x, unsigned& nloc, unsigned& nx) {
    const unsigned G = gridDim.x * gridDim.y * gridDim.z;
    unsigned sum, cnt, mine, sp = 0u;
    for (;;) {
        sum = 0u; cnt = 0u; mine = 0u;
#pragma unroll
        for (unsigned j = 0; j < 16; ++j) { const unsigned c = xb_ld(&bar[XB_XCNT(j)]); sum += c; cnt += (c > 0u) ? 1u : 0u; mine = (j == x) ? c : mine; }
        if (sum == G) break;
        __builtin_amdgcn_s_sleep(1);
        if ((++sp & 255u) == 0u) { if (xb_ld(&bar[XB_TMO])) break; if (sp > XB_SPIN_CAP) { atomicAdd(&bar[XB_TMO], 1u); break; } }
    }
    nloc = mine > 0u ? mine : 1u; nx = cnt > 0u ? cnt : 1u;
}

__device__ __forceinline__ void xcd_barrier(const XcdBarrier& b) {
    asm volatile("s_waitcnt vmcnt(0)" ::: "memory");
    __syncthreads();
    if (threadIdx.x == 0) {
        unsigned* bar = b.bar;
        __builtin_amdgcn_s_waitcnt(0);
        unsigned nloc = b.st[0], nx = b.st[1];
        if (nloc == 0u) { xcd_barrier_complete(bar, b.x, nloc, nx); b.st[0] = nloc; b.st[1] = nx; }
        const unsigned old = xb_add(&bar[XB_XSUB(b.x)], 1u);
        const unsigned gen = old / nloc;
        if (old + 1u == (gen + 1u) * nloc) {
            __builtin_amdgcn_fence(__ATOMIC_RELEASE, "agent");
            asm volatile("s_waitcnt vmcnt(0)" ::: "memory");
            const unsigned og = xb_add(&bar[XB_TOP], 1u);
            const unsigned tg = og / nx;
            if (og + 1u == (tg + 1u) * nx) xb_add(&bar[XB_TOPGEN], 1u);
            else XB_SPIN(xb_ld(&bar[XB_TOPGEN]) == tg, bar);
            __builtin_amdgcn_fence(__ATOMIC_ACQUIRE, "agent");
            xb_add(&bar[XB_XGEN(b.x)], 1u);
            asm volatile("s_waitcnt vmcnt(0)" ::: "memory");
        } else {
            XB_SPIN(xb_ld(&bar[XB_XGEN(b.x)]) == gen, bar);
            __builtin_amdgcn_fence(__ATOMIC_ACQUIRE, "agent");
            asm volatile("s_waitcnt vmcnt(0)" ::: "memory");
        }
    }
    __syncthreads();
}

namespace cg = cooperative_groups;
constexpr int NWAVES = 8, NTHR = 512;
constexpr int DM = 1024, NBP = 8, SEQ = 2048, NBS = 128, DSEQ = 8, MP = NBP * SEQ, MS = NBS * DSEQ, MT = MP + MS, NSEQ = NBP + NBS;
constexpr int NIN = 3072, DFF = 2816, NGU = 2 * DFF, NMOD = 6 * DM;
constexpr int ZQ = 0, ZF = 512, ZI = 1024, ZG = 1536, ZU = 2048, ZV = 2560;
constexpr float EPS = 1e-6f;
constexpr size_t O_Y = 0, O_SP = (size_t)MT * DM, O_SS = O_SP + (size_t)NBP * 4 * 16384, O_VP = O_SS + (size_t)NBS * 4 * 16384, O_VS = O_VP + (size_t)NBP * 128 * 512;
constexpr size_t MiB = 1u << 20;
constexpr size_t OUT_QD = 0, OUT_OI = 16 * MiB;
constexpr size_t WS_CTL = 0, CTL_ZERO_BYTES = 64 * 1024;
constexpr size_t WS_WIN = 1 * MiB, WS_WOUT = 7 * MiB, WS_WGU = 9 * MiB, WS_WDN = 20 * MiB, WS_MOD = 26 * MiB, WS_SC = 30 * MiB, WS_DEC = 31 * MiB;
constexpr size_t WS_H = 32 * MiB, WS_Z = 66 * MiB, WS_DS = 168 * MiB, WS_END = 232 * MiB;
constexpr size_t WS_ACT = WS_Z, WS_MB = WS_DS, WS_FB = WS_DS, WS_PART = 208 * MiB;
static_assert(WS_WDN + (size_t)DM * DFF * 2 <= WS_MOD && WS_MOD + (size_t)NSEQ * NMOD * 4 <= WS_SC && WS_H + (size_t)MT * DM * 2 <= WS_Z && WS_Z + (size_t)MT * NIN * 2 <= WS_DS, "ws map");
static_assert(WS_FB + (size_t)MT * DM * 2 <= WS_PART && WS_PART + (size_t)11 * MS * DM * 4 <= 256 * MiB && WS_ACT + (size_t)MT * DFF * 2 <= WS_DS && WS_DS + (size_t)1024 * 16384 * 4 <= WS_END, "ws map 2");
constexpr int CW_BAR = 4096;
constexpr int RING_BYTES = 131072, LDSCTL_OFF = RING_BYTES, MISC_OFF = LDSCTL_OFF + 320, LDS_BYTES = 147456;
constexpr int NPH = 12;
#ifndef MK_N_LAUNCHES
#define MK_N_LAUNCHES 1
#endif

__device__ __forceinline__ float wave_sum(float v) {
#pragma unroll
    for (int o = 1; o < 64; o <<= 1) v += __shfl_xor(v, o);
    return v;
}
__device__ __forceinline__ float bflo(unsigned u) { return __uint_as_float(u << 16); }
__device__ __forceinline__ float bfhi(unsigned u) { return __uint_as_float(u & 0xffff0000u); }
__device__ __forceinline__ float rcp_f(float x) { return __builtin_amdgcn_rcpf(x); }
__device__ __forceinline__ float sigm_f(float x) { return rcp_f(1.f + __expf(-x)); }
__device__ __forceinline__ float silu2_f(float x) { return x * sigm_f(x); }
__device__ __forceinline__ float gelu_f(float x) { return x * sigm_f(1.5957691216057308f * (x + 0.044715f * x * x * x)); }
__device__ __forceinline__ bf16x8 pack8(f32x4 a, f32x4 b) { v4u t; t.x = pg8::cvt_pk_bf16(a[0], a[1]); t.y = pg8::cvt_pk_bf16(a[2], a[3]); t.z = pg8::cvt_pk_bf16(b[0], b[1]); t.w = pg8::cvt_pk_bf16(b[2], b[3]); return __builtin_bit_cast(bf16x8, t); }
#define MFMA16(a, b, c) __builtin_amdgcn_mfma_f32_16x16x32_bf16((a), (b), (c), 0, 0, 0)

struct Args { const float* in[22]; float* out; unsigned char* ws; int ph_lo, ph_hi, use_cg, pad; };
struct Ctx { LAS unsigned char* lds; int tid, lane, wave, vcu, G; };

__device__ __forceinline__ void transpose_item(const float* W, int K, int N, bf16* WT, int kb, int n0, int drow0, LAS float* scr, int lane) {
    const int k0 = 64 * kb;
    float tv[32];
#pragma unroll
    for (int i = 0; i < 32; ++i) tv[i] = W[(size_t)(k0 + 2 * i + (lane >> 5)) * N + n0 + (lane & 31)];
#pragma unroll
    for (int i = 0; i < 32; ++i) scr[(2 * i + (lane >> 5)) * 33 + (lane & 31)] = tv[i];
    LDS_WAIT(); asm volatile("" ::: "memory");
    const int c = lane & 7;
#pragma unroll
    for (int j = 0; j < 4; ++j) { const int n = (lane >> 3) + 8 * j; const LAS float* s = scr + (8 * c) * 33 + n;
        v4u o; o.x = pk2(s[0 * 33], s[1 * 33]); o.y = pk2(s[2 * 33], s[3 * 33]); o.z = pk2(s[4 * 33], s[5 * 33]); o.w = pk2(s[6 * 33], s[7 * 33]);
        *(v4u*)(WT + (size_t)(drow0 + n) * K + k0 + 8 * c) = o; }
    LDS_WAIT(); asm volatile("" ::: "memory");
}
__device__ __forceinline__ void phase_p0(const Args& a, const Ctx& C) {
    unsigned char* ws = a.ws;
    { bf16* SC = (bf16*)(ws + WS_SC); const float* cp = a.in[3]; const float* cs = a.in[4];
      for (int e = C.vcu * NTHR + C.tid; e < 144 * DM; e += C.G * NTHR) { const int r = e >> 10; float v = 0.f;
          if (r < NBP) v = silu2_f(cp[e]); else if (r < NSEQ) v = silu2_f(cs[e - NBP * DM]);
          SC[e] = (bf16)f2bf(v); } }
    LAS float* scr = (LAS float*)(C.lds + C.wave * 16384);
    const int gw = C.vcu * NWAVES + C.wave, NGW = C.G * NWAVES;
    constexpr int I_IN = 16 * 96, I_OUT = 16 * 32, I_G = 16 * 88, I_D = 44 * 32, NITEMS = I_IN + I_OUT + 2 * I_G + I_D;
    for (int it = gw; it < NITEMS; it += NGW) {
        int r = it;
        if (r < I_IN) { const int kb = r / 96, n0 = 32 * (r % 96); transpose_item(a.in[10], DM, NIN, (bf16*)(ws + WS_WIN), kb, n0, n0, scr, C.lane); continue; } r -= I_IN;
        if (r < I_OUT) { const int kb = r / 32, n0 = 32 * (r % 32); transpose_item(a.in[16], DM, DM, (bf16*)(ws + WS_WOUT), kb, n0, n0, scr, C.lane); continue; } r -= I_OUT;
        if (r < I_G) { const int kb = r / 88, n0 = 32 * (r % 88); transpose_item(a.in[19], DM, DFF, (bf16*)(ws + WS_WGU), kb, n0, 256 * (n0 >> 7) + (n0 & 127), scr, C.lane); continue; } r -= I_G;
        if (r < I_G) { const int kb = r / 88, n0 = 32 * (r % 88); transpose_item(a.in[20], DM, DFF, (bf16*)(ws + WS_WGU), kb, n0, 256 * (n0 >> 7) + 128 + (n0 & 127), scr, C.lane); continue; } r -= I_G;
        { const int kb = r / 32, n0 = 32 * (r % 32); transpose_item(a.in[21], DFF, DM, (bf16*)(ws + WS_WDN), kb, n0, n0, scr, C.lane); }
    }
}
__device__ __forceinline__ void phase_mod(const Args& a, const Ctx& C) {
    const bf16* SC = (const bf16*)(a.ws + WS_SC); const float* wada = a.in[6]; const float* bada = a.in[7]; float* MOD = (float*)(a.ws + WS_MOD);
    const int i = C.lane & 15, kq = C.lane >> 4;
    LAS f32x4* RED = (LAS f32x4*)C.lds;
    for (int strip = C.vcu; strip < NMOD / 16; strip += C.G) {
        const int n0 = strip * 16;
        f32x4 acc[9];
#pragma unroll
        for (int rb = 0; rb < 9; ++rb) acc[rb] = (f32x4){0.f, 0.f, 0.f, 0.f};
#pragma unroll 2
        for (int kk = 0; kk < 4; ++kk) {
            const int k0 = (C.wave * 4 + kk) * 32 + kq * 8;
            const float* wp = wada + (size_t)k0 * NMOD + n0 + i;
            f32x4 w0, w1;
            w0[0] = wp[0]; w0[1] = wp[(size_t)NMOD]; w0[2] = wp[(size_t)2 * NMOD]; w0[3] = wp[(size_t)3 * NMOD];
            w1[0] = wp[(size_t)4 * NMOD]; w1[1] = wp[(size_t)5 * NMOD]; w1[2] = wp[(size_t)6 * NMOD]; w1[3] = wp[(size_t)7 * NMOD];
            const bf16x8 af = pack8(w0, w1);
#pragma unroll
            for (int rb = 0; rb < 9; ++rb) { const bf16x8 bfr = *(const bf16x8*)(SC + (size_t)(rb * 16 + i) * DM + k0); acc[rb] = MFMA16(af, bfr, acc[rb]); }
        }
#pragma unroll
        for (int rb = 0; rb < 9; ++rb) RED[(C.wave * 9 + rb) * 64 + C.lane] = acc[rb];
        __syncthreads();
        for (int slot = C.tid; slot < 9 * 64; slot += NTHR) { const int rb = slot >> 6, ln = slot & 63, r = rb * 16 + (ln & 15), n = n0 + (ln >> 4) * 4;
            f32x4 sum = *(const f32x4*)(bada + n);
#pragma unroll
            for (int ww = 0; ww < 8; ++ww) sum += RED[(ww * 9 + rb) * 64 + ln];
            if (r < NSEQ) *(f32x4*)(MOD + (size_t)r * NMOD + n) = sum; }
        __syncthreads();
    }
}
__device__ __forceinline__ const float* xrow_ptr(const Args& a, int m) { return m < MP ? a.in[0] + (size_t)m * DM : a.in[1] + (size_t)(m - MP) * DM; }
__device__ __forceinline__ int seq_of(int m) { return m < MP ? (m >> 11) : NBP + ((m - MP) >> 3); }
__device__ __forceinline__ void store4bf(bf16* p, f32x4 v) { v2u o; o.x = pg8::cvt_pk_bf16(v[0], v[1]); o.y = pg8::cvt_pk_bf16(v[2], v[3]); *(v2u*)p = o; }
__device__ __forceinline__ f32x4 load4bf(const bf16* p) { const v2u w = *(const v2u*)p; return (f32x4){bflo(w.x), bfhi(w.x), bflo(w.y), bfhi(w.y)}; }
#define SQ4(v) (((v)[0] * (v)[0] + (v)[1] * (v)[1]) + ((v)[2] * (v)[2] + (v)[3] * (v)[3]))
__device__ __forceinline__ void phase_p1(const Args& a, const Ctx& C) {
    const float* MOD = (const float*)(a.ws + WS_MOD); bf16* H = (bf16*)(a.ws + WS_H); const float* npm = a.in[8];
    const int NGW = C.G * NWAVES; int m = C.vcu * NWAVES + C.wave;
    f32x4 nv[4];
    if (m < MT) { const float* xr = xrow_ptr(a, m);
#pragma unroll
        for (int j = 0; j < 4; ++j) nv[j] = *(const f32x4*)(xr + 4 * C.lane + 256 * j); }
    for (; m < MT; m += NGW) {
        f32x4 v[4];
#pragma unroll
        for (int j = 0; j < 4; ++j) v[j] = nv[j];
        if (m + NGW < MT) { const float* xr = xrow_ptr(a, m + NGW);
#pragma unroll
            for (int j = 0; j < 4; ++j) nv[j] = *(const f32x4*)(xr + 4 * C.lane + 256 * j); }
        const float* md = MOD + (size_t)seq_of(m) * NMOD;
        float ss = 0.f;
#pragma unroll
        for (int j = 0; j < 4; ++j) ss += SQ4(v[j]);
        const float rs = rsqrtf(wave_sum(ss) * (1.f / DM) + EPS);
#pragma unroll
        for (int j = 0; j < 4; ++j) { const int c = 4 * C.lane + 256 * j;
            const f32x4 g = *(const f32x4*)(npm + c), sh = *(const f32x4*)(md + c), sc = *(const f32x4*)(md + DM + c);
            store4bf(H + (size_t)m * DM + c, v[j] * rs * g * (sc + 1.f) + sh); }
    }
}
__device__ __forceinline__ void load_mrow(const Args& a, const bf16* MB, int m, int lane, int nparts, f32x4 (&mv)[4]) {
#pragma unroll
    for (int j = 0; j < 4; ++j) { const int c = 4 * lane + 256 * j;
        if (m < MP) mv[j] = load4bf(MB + (size_t)m * DM + c);
        else { const float* pp = (const float*)(a.ws + WS_PART) + (size_t)(m - MP) * DM + c; mv[j] = *(const f32x4*)pp;
            for (int q = 1; q < nparts; ++q) mv[j] += *(const f32x4*)(pp + (size_t)q * MS * DM); } }
}
__device__ __forceinline__ void phase_p5(const Args& a, const Ctx& C) {
    const float* MOD = (const float*)(a.ws + WS_MOD); bf16* H = (bf16*)(a.ws + WS_H); const bf16* MB = (const bf16*)(a.ws + WS_MB);
    const float* npost = a.in[9]; const float* npre = a.in[17];
    const int NGW = C.G * NWAVES; int m = C.vcu * NWAVES + C.wave;
    f32x4 nm[4], nx[4];
    if (m < MT) { load_mrow(a, MB, m, C.lane, 4, nm); const float* xr = xrow_ptr(a, m);
#pragma unroll
        for (int j = 0; j < 4; ++j) nx[j] = *(const f32x4*)(xr + 4 * C.lane + 256 * j); }
    for (; m < MT; m += NGW) {
        f32x4 mv[4], x1[4];
#pragma unroll
        for (int j = 0; j < 4; ++j) { mv[j] = nm[j]; x1[j] = nx[j]; }
        if (m + NGW < MT) { load_mrow(a, MB, m + NGW, C.lane, 4, nm); const float* xr = xrow_ptr(a, m + NGW);
#pragma unroll
            for (int j = 0; j < 4; ++j) nx[j] = *(const f32x4*)(xr + 4 * C.lane + 256 * j); }
        const float* md = MOD + (size_t)seq_of(m) * NMOD;
        float ss = 0.f;
#pragma unroll
        for (int j = 0; j < 4; ++j) ss += SQ4(mv[j]);
        const float rs = rsqrtf(wave_sum(ss) * (1.f / DM) + EPS);
        float ss2 = 0.f;
#pragma unroll
        for (int j = 0; j < 4; ++j) { const int c = 4 * C.lane + 256 * j;
            const f32x4 g = *(const f32x4*)(npost + c), g1 = *(const f32x4*)(md + 2 * DM + c);
            x1[j] = x1[j] + g1 * (mv[j] * rs * g);
            *(f32x4*)(a.out + O_Y + (size_t)m * DM + c) = x1[j];
            ss2 += SQ4(x1[j]); }
        const float rs2 = rsqrtf(wave_sum(ss2) * (1.f / DM) + EPS);
#pragma unroll
        for (int j = 0; j < 4; ++j) { const int c = 4 * C.lane + 256 * j;
            const f32x4 g = *(const f32x4*)(npre + c), sh = *(const f32x4*)(md + 3 * DM + c), sc = *(const f32x4*)(md + 4 * DM + c);
            store4bf(H + (size_t)m * DM + c, x1[j] * rs2 * g * (sc + 1.f) + sh); }
    }
}
__device__ __forceinline__ void phase_p8(const Args& a, const Ctx& C) {
    const float* MOD = (const float*)(a.ws + WS_MOD); const bf16* FB = (const bf16*)(a.ws + WS_FB); const float* npf = a.in[18];
    const int NGW = C.G * NWAVES; int m = C.vcu * NWAVES + C.wave;
    f32x4 nf[4], nx[4];
    if (m < MT) { load_mrow(a, FB, m, C.lane, 11, nf);
#pragma unroll
        for (int j = 0; j < 4; ++j) nx[j] = *(const f32x4*)(a.out + O_Y + (size_t)m * DM + 4 * C.lane + 256 * j); }
    for (; m < MT; m += NGW) {
        f32x4 fv[4], x1[4];
#pragma unroll
        for (int j = 0; j < 4; ++j) { fv[j] = nf[j]; x1[j] = nx[j]; }
        if (m + NGW < MT) { load_mrow(a, FB, m + NGW, C.lane, 11, nf);
#pragma unroll
            for (int j = 0; j < 4; ++j) nx[j] = *(const f32x4*)(a.out + O_Y + (size_t)(m + NGW) * DM + 4 * C.lane + 256 * j); }
        const float* md = MOD + (size_t)seq_of(m) * NMOD;
        float ss = 0.f;
#pragma unroll
        for (int j = 0; j < 4; ++j) ss += SQ4(fv[j]);
        const float rs = rsqrtf(wave_sum(ss) * (1.f / DM) + EPS);
#pragma unroll
        for (int j = 0; j < 4; ++j) { const int c = 4 * C.lane + 256 * j;
            const f32x4 g = *(const f32x4*)(npf + c), g2 = *(const f32x4*)(md + 5 * DM + c);
            *(f32x4*)(a.out + O_Y + (size_t)m * DM + c) = x1[j] + g2 * (fv[j] * rs * g); }
    }
}
constexpr int A_LF = 0, A_LFS = 132, A_PT = 33792, A_QD = 35840, A_KD = 53248, A_KET = 70656, A_VT = 89088, A_PP = 107520, A_LB = 116736;
__device__ __forceinline__ void unpack16(const v4u a, const v4u b, float (&z)[16]) {
    z[0] = bflo(a.x); z[1] = bfhi(a.x); z[2] = bflo(a.y); z[3] = bfhi(a.y); z[4] = bflo(a.z); z[5] = bfhi(a.z); z[6] = bflo(a.w); z[7] = bfhi(a.w);
    z[8] = bflo(b.x); z[9] = bfhi(b.x); z[10] = bflo(b.y); z[11] = bfhi(b.y); z[12] = bflo(b.z); z[13] = bfhi(b.z); z[14] = bflo(b.w); z[15] = bfhi(b.w);
}
__device__ __forceinline__ void hgrn_pass_a(const Args& a, const Ctx& C, int item) {
    const bf16* Z = (const bf16*)(a.ws + WS_Z); float* DS = (float*)(a.ws + WS_DS); float* DEC = (float*)(a.ws + WS_DEC);
    bf16* QDG = (bf16*)((unsigned char*)a.out + OUT_QD); float* OI = (float*)((unsigned char*)a.out + OUT_OI);
    const float* lbl = a.in[5];
    const int bh = item >> 5, n = item & 31, b = bh >> 2, h = bh & 3, tok0 = b * SEQ + n * 64;
    LAS unsigned char* lds = C.lds; LAS float* LF = (LAS float*)(lds + A_LF); LAS float* PT = (LAS float*)(lds + A_PT); LAS float* LB = (LAS float*)(lds + A_LB);
    const int tid = C.tid, w = C.wave, i = C.lane & 15, kq = C.lane >> 4;
    if (tid < 128) { const float l0 = lbl[h * 128 + tid], l1 = lbl[512 + h * 128 + tid]; LB[tid] = rcp_f(1.f + __expf(l1 - l0)); }
    __syncthreads();
    const int t = tid >> 3, c0 = (tid & 7) * 16;
    const bf16* zrow = Z + (size_t)(tok0 + t) * NIN + h * 128 + c0;
    float kk[16];
    const v4u f0 = *(const v4u*)(zrow + ZF), f1 = *(const v4u*)(zrow + ZF + 8);
    const v4u q0 = *(const v4u*)(zrow + ZQ), q1 = *(const v4u*)(zrow + ZQ + 8), i0 = *(const v4u*)(zrow + ZI), i1 = *(const v4u*)(zrow + ZI + 8);
    { float z[16]; unpack16(f0, f1, z);
#pragma unroll
      for (int j = 0; j < 16; ++j) { const float lb = LB[c0 + j], sg = sigm_f(z[j]); const float f = lb + (1.f - lb) * sg; kk[j] = (1.f - lb) * (1.f - sg); LF[t * A_LFS + c0 + j] = __logf(f); } }
    __syncthreads();
    { const int k = tid & 127, part = tid >> 7; float run = 0.f;
#pragma unroll
      for (int r = 0; r < 16; ++r) { LAS float* p = LF + (part * 16 + r) * A_LFS + k; run += *p; *p = run; }
      PT[part * 128 + k] = run; }
    __syncthreads();
    { const int k = tid & 127, part = tid >> 7;
      const float off = (part > 0 ? PT[k] : 0.f) + (part > 1 ? PT[128 + k] : 0.f) + (part > 2 ? PT[256 + k] : 0.f);
      if (part > 0) {
#pragma unroll
          for (int r = 0; r < 16; ++r) LF[(part * 16 + r) * A_LFS + k] += off; } }
    __syncthreads();
    { float q[16]; unpack16(q0, q1, q);
      float qd[16], kd[16], ke[16];
#pragma unroll
      for (int j = 0; j < 16; ++j) { const float bb = LF[t * A_LFS + c0 + j], bl = LF[63 * A_LFS + c0 + j];
          qd[j] = q[j] * __expf(bb); kd[j] = kk[j] * __expf(-bb); ke[j] = kk[j] * __expf(bl - bb);
          if (t == 63) DEC[(size_t)item * 128 + c0 + j] = __expf(bl); }
      v4u o0, o1;
      o0.x = pg8::cvt_pk_bf16(qd[0], qd[1]); o0.y = pg8::cvt_pk_bf16(qd[2], qd[3]); o0.z = pg8::cvt_pk_bf16(qd[4], qd[5]); o0.w = pg8::cvt_pk_bf16(qd[6], qd[7]);
      o1.x = pg8::cvt_pk_bf16(qd[8], qd[9]); o1.y = pg8::cvt_pk_bf16(qd[10], qd[11]); o1.z = pg8::cvt_pk_bf16(qd[12], qd[13]); o1.w = pg8::cvt_pk_bf16(qd[14], qd[15]);
      *(LAS v4u*)(lds + A_QD + t * 272 + c0 * 2) = o0; *(LAS v4u*)(lds + A_QD + t * 272 + c0 * 2 + 16) = o1;
      bf16* qg = QDG + (size_t)(tok0 + t) * 512 + h * 128 + c0; *(v4u*)qg = o0; *(v4u*)(qg + 8) = o1;
      o0.x = pg8::cvt_pk_bf16(kd[0], kd[1]); o0.y = pg8::cvt_pk_bf16(kd[2], kd[3]); o0.z = pg8::cvt_pk_bf16(kd[4], kd[5]); o0.w = pg8::cvt_pk_bf16(kd[6], kd[7]);
      o1.x = pg8::cvt_pk_bf16(kd[8], kd[9]); o1.y = pg8::cvt_pk_bf16(kd[10], kd[11]); o1.z = pg8::cvt_pk_bf16(kd[12], kd[13]); o1.w = pg8::cvt_pk_bf16(kd[14], kd[15]);
      *(LAS v4u*)(lds + A_KD + t * 272 + c0 * 2) = o0; *(LAS v4u*)(lds + A_KD + t * 272 + c0 * 2 + 16) = o1;
      const unsigned vi[8] = {i0.x, i0.y, i0.z, i0.w, i1.x, i1.y, i1.z, i1.w};
#pragma unroll
      for (int j = 0; j < 16; ++j) {
          *(LAS unsigned short*)(lds + A_KET + (c0 + j) * 144 + t * 2) = (unsigned short)f2bf(ke[j]);
          *(LAS unsigned short*)(lds + A_VT + (c0 + j) * 144 + t * 2) = (unsigned short)((j & 1) ? (vi[j >> 1] >> 16) : (vi[j >> 1] & 0xffffu)); } }
    __syncthreads();
    { const int tb = w >> 1;
#pragma unroll
      for (int e = 0; e < 2; ++e) { const int sb = 2 * (w & 1) + e; f32x4 acc = (f32x4){0.f, 0.f, 0.f, 0.f};
#pragma unroll
          for (int ks = 0; ks < 4; ++ks) { const bf16x8 A = *(const LAS bf16x8*)(lds + A_KD + (16 * sb + i) * 272 + (ks * 32 + kq * 8) * 2), B = *(const LAS bf16x8*)(lds + A_QD + (16 * tb + i) * 272 + (ks * 32 + kq * 8) * 2);
              acc = MFMA16(A, B, acc); }
          const int tt = 16 * tb + i, s0 = 16 * sb + kq * 4;
          v2u o; o.x = pg8::cvt_pk_bf16(s0 <= tt ? acc[0] : 0.f, s0 + 1 <= tt ? acc[1] : 0.f); o.y = pg8::cvt_pk_bf16(s0 + 2 <= tt ? acc[2] : 0.f, s0 + 3 <= tt ? acc[3] : 0.f);
          *(LAS v2u*)(lds + A_PP + tt * 144 + s0 * 2) = o; } }
    { bf16x8 A2[2];
#pragma unroll
      for (int sc = 0; sc < 2; ++sc) A2[sc] = *(const LAS bf16x8*)(lds + A_KET + (16 * w + i) * 144 + (sc * 32 + kq * 8) * 2);
#pragma unroll
      for (int vb = 0; vb < 8; ++vb) { f32x4 acc = (f32x4){0.f, 0.f, 0.f, 0.f};
#pragma unroll
          for (int sc = 0; sc < 2; ++sc) { const bf16x8 B = *(const LAS bf16x8*)(lds + A_VT + (16 * vb + i) * 144 + (sc * 32 + kq * 8) * 2); acc = MFMA16(A2[sc], B, acc); }
          *(f32x4*)(DS + (size_t)item * 16384 + (16 * vb + i) * 128 + 16 * w + kq * 4) = acc; } }
    __syncthreads();
    { bf16x8 A3[2];
#pragma unroll
      for (int sc = 0; sc < 2; ++sc) A3[sc] = *(const LAS bf16x8*)(lds + A_VT + (16 * w + i) * 144 + (sc * 32 + kq * 8) * 2);
#pragma unroll
      for (int tb = 0; tb < 4; ++tb) { f32x4 acc = (f32x4){0.f, 0.f, 0.f, 0.f};
#pragma unroll
          for (int sc = 0; sc < 2; ++sc) { const bf16x8 B = *(const LAS bf16x8*)(lds + A_PP + (16 * tb + i) * 144 + (sc * 32 + kq * 8) * 2); acc = MFMA16(A3[sc], B, acc); }
          *(f32x4*)(OI + (size_t)(tok0 + 16 * tb + i) * 512 + h * 128 + 16 * w + kq * 4) = acc; } }
    __syncthreads();
}
__device__ __forceinline__ void hgrn_sample(const Args& a, const Ctx& C, int item) {
    const bf16* Z = (const bf16*)(a.ws + WS_Z); bf16* H = (bf16*)(a.ws + WS_H); const float* lbl = a.in[5]; const float* gnw = a.in[11];
    const int b = item >> 2, h = item & 3, m0 = MP + b * DSEQ, tid = C.tid;
    LAS float* F8 = (LAS float*)C.lds; LAS float* K8 = F8 + 1024; LAS float* Q8 = F8 + 2048; LAS float* V8 = F8 + 3072; LAS float* OP = F8 + 4096;
    const int v = tid & 127, kp = tid >> 7;
    const size_t sbase = ((size_t)item * 128 + kp * 32) * 128 + v;
    const float* s0 = a.in[2] + sbase;
    float S[32];
#pragma unroll
    for (int r = 0; r < 32; ++r) S[r] = s0[(size_t)r * 128];
    for (int idx = tid; idx < 1024; idx += NTHR) { const int t = idx >> 7, k = idx & 127; const bf16* zr = Z + (size_t)(m0 + t) * NIN + h * 128 + k;
        const float l0 = lbl[h * 128 + k], l1 = lbl[512 + h * 128 + k], lb = rcp_f(1.f + __expf(l1 - l0));
        const float sg = sigm_f(bflo(zr[ZF])); F8[idx] = lb + (1.f - lb) * sg; K8[idx] = (1.f - lb) * (1.f - sg); Q8[idx] = bflo(zr[ZQ]); V8[idx] = bflo(zr[ZI]); }
    __syncthreads();
#pragma unroll 1
    for (int t = 0; t < DSEQ; ++t) { const float vt = V8[t * 128 + v]; float o = 0.f;
#pragma unroll
        for (int r4 = 0; r4 < 8; ++r4) { const f32x4 f = *(const LAS f32x4*)(F8 + t * 128 + kp * 32 + r4 * 4), kx = *(const LAS f32x4*)(K8 + t * 128 + kp * 32 + r4 * 4), qx = *(const LAS f32x4*)(Q8 + t * 128 + kp * 32 + r4 * 4);
#pragma unroll
            for (int e = 0; e < 4; ++e) { S[r4 * 4 + e] = f[e] * S[r4 * 4 + e] + kx[e] * vt; o += S[r4 * 4 + e] * qx[e]; } }
        OP[(t * 4 + kp) * 128 + v] = o; }
    float* so = a.out + O_SS + sbase;
#pragma unroll
    for (int r = 0; r < 32; ++r) so[(size_t)r * 128] = S[r];
    __syncthreads();
    { const int t = C.wave, l = C.lane;
      const float o0 = (OP[(t * 4 + 0) * 128 + l] + OP[(t * 4 + 1) * 128 + l]) + (OP[(t * 4 + 2) * 128 + l] + OP[(t * 4 + 3) * 128 + l]);
      const float o1 = (OP[(t * 4 + 0) * 128 + 64 + l] + OP[(t * 4 + 1) * 128 + 64 + l]) + (OP[(t * 4 + 2) * 128 + 64 + l] + OP[(t * 4 + 3) * 128 + 64 + l]);
      const float rs = rsqrtf(wave_sum(o0 * o0 + o1 * o1) * (1.f / 128.f) + EPS);
      const bf16* zg = Z + (size_t)(m0 + t) * NIN + ZG + h * 128; bf16* hp = H + (size_t)(m0 + t) * DM + h * 128;
      hp[l] = (bf16)f2bf(o0 * rs * gnw[l] * silu2_f(bflo(zg[l]))); hp[64 + l] = (bf16)f2bf(o1 * rs * gnw[64 + l] * silu2_f(bflo(zg[64 + l]))); }
    __syncthreads();
}
__device__ __forceinline__ void cmlp_prompt(const Args& a, const Ctx& C, int item) {
    const bf16* Z = (const bf16*)(a.ws + WS_Z); bf16* H = (bf16*)(a.ws + WS_H);
    const float* lng = a.in[12]; const float* lnb = a.in[13]; const float* wsp = a.in[14]; const float* bsp = a.in[15];
    const int g = item & 3, c = (item >> 2) & 15, b = item >> 6, tok0 = b * SEQ + c * 128;
    LAS unsigned char* lds = C.lds; const int tid = C.tid, w = C.wave, i = C.lane & 15, kq = C.lane >> 4;
    const int t = 16 * w + i, nks = (w >> 1) + 1;
    bf16x8 Bf[4]; v2u zuv[8]; float bs;
    { const float* wr = wsp + (size_t)g * 16384 + (size_t)t * 128 + kq * 8;
#pragma unroll
      for (int ks = 0; ks < 4; ++ks) { f32x4 b0 = (f32x4){0.f, 0.f, 0.f, 0.f}, b1 = b0;
          if (ks < nks) { b0 = *(const f32x4*)(wr + ks * 32); b1 = *(const f32x4*)(wr + ks * 32 + 4); }
          const int sb = ks * 32 + kq * 8;
#pragma unroll
          for (int e = 0; e < 4; ++e) { b0[e] = (sb + e <= t) ? b0[e] : 0.f; b1[e] = (sb + 4 + e <= t) ? b1[e] : 0.f; }
          Bf[ks] = pack8(b0, b1); }
      bs = bsp[g * 128 + t];
      const bf16* zu = Z + (size_t)(tok0 + t) * NIN + ZU + g * 128 + kq * 4;
#pragma unroll
      for (int db = 0; db < 8; ++db) zuv[db] = *(const v2u*)(zu + 16 * db); }
    { const int s = tid >> 2, part = tid & 3;
      const bf16* zr = Z + (size_t)(tok0 + s) * NIN + ZV + part * 128; float s1 = 0.f, s2 = 0.f;
#pragma unroll 4
      for (int q = 0; q < 16; ++q) { const v4u wv = *(const v4u*)(zr + q * 8); const unsigned u4[4] = {wv.x, wv.y, wv.z, wv.w};
#pragma unroll
          for (int e = 0; e < 4; ++e) { const float x0 = gelu_f(bflo(u4[e])), x1 = gelu_f(bfhi(u4[e])); s1 += x0 + x1; s2 += x0 * x0 + x1 * x1; } }
      s1 += __shfl_xor(s1, 1); s2 += __shfl_xor(s2, 1); s1 += __shfl_xor(s1, 2); s2 += __shfl_xor(s2, 2);
      const float mean = s1 * (1.f / 512.f), var = fmaxf(s2 * (1.f / 512.f) - mean * mean, 0.f), rstd = rsqrtf(var + EPS);
      const bf16* zr2 = Z + (size_t)(tok0 + s) * NIN + ZV + g * 128 + part * 32;
      float* vout = a.out + O_VP + ((size_t)(b * 128 + s)) * 512 + g * 128 + part * 32;
#pragma unroll
      for (int q = 0; q < 4; ++q) { const v4u wv = *(const v4u*)(zr2 + q * 8); const unsigned u4[4] = {wv.x, wv.y, wv.z, wv.w};
          const int d0 = part * 32 + q * 8; float vv[8];
#pragma unroll
          for (int e = 0; e < 4; ++e) { vv[2 * e] = gelu_f(bflo(u4[e])); vv[2 * e + 1] = gelu_f(bfhi(u4[e])); }
          const f32x4 ga = *(const f32x4*)(lng + g * 128 + d0), gb = *(const f32x4*)(lng + g * 128 + d0 + 4), ba = *(const f32x4*)(lnb + g * 128 + d0), bb = *(const f32x4*)(lnb + g * 128 + d0 + 4);
#pragma unroll
          for (int e = 0; e < 8; ++e) { vv[e] = (vv[e] - mean) * rstd * (e < 4 ? ga[e & 3] : gb[e & 3]) + (e < 4 ? ba[e & 3] : bb[e & 3]);
              *(LAS unsigned short*)(lds + (d0 + e) * 272 + s * 2) = (unsigned short)f2bf(vv[e]); }
          if (c == 15) { *(f32x4*)(vout + q * 8) = (f32x4){vv[0], vv[1], vv[2], vv[3]}; *(f32x4*)(vout + q * 8 + 4) = (f32x4){vv[4], vv[5], vv[6], vv[7]}; } } }
    __syncthreads();
    { f32x4 acc[8];
#pragma unroll
      for (int db = 0; db < 8; ++db) acc[db] = (f32x4){0.f, 0.f, 0.f, 0.f};
#pragma unroll
      for (int ks = 0; ks < 4; ++ks) if (ks < nks) {
#pragma unroll
          for (int db = 0; db < 8; ++db) { const bf16x8 A = *(const LAS bf16x8*)(lds + (16 * db + i) * 272 + (ks * 32 + kq * 8) * 2); acc[db] = MFMA16(A, Bf[ks], acc[db]); } }
      bf16* hp = H + (size_t)(tok0 + t) * DM + 512 + g * 128 + kq * 4;
#pragma unroll
      for (int db = 0; db < 8; ++db) { const f32x4 u = (f32x4){bflo(zuv[db].x), bfhi(zuv[db].x), bflo(zuv[db].y), bfhi(zuv[db].y)};
          store4bf(hp + 16 * db, (f32x4){gelu_f(u[0]) * (acc[db][0] + bs), gelu_f(u[1]) * (acc[db][1] + bs), gelu_f(u[2]) * (acc[db][2] + bs), gelu_f(u[3]) * (acc[db][3] + bs)}); } }
    __syncthreads();
}
__device__ __forceinline__ void cmlp_sample(const Args& a, const Ctx& C, int b) {
    const bf16* Z = (const bf16*)(a.ws + WS_Z); bf16* H = (bf16*)(a.ws + WS_H);
    const float* lng = a.in[12]; const float* lnb = a.in[13]; const float* wsp = a.in[14]; const float* bsp = a.in[15];
    const int m0 = MP + b * DSEQ, t = C.wave, c0 = C.lane * 8, g = c0 >> 7;
    LAS float* VS = (LAS float*)C.lds;
    const bf16* zr = Z + (size_t)(m0 + t) * NIN;
    const v4u zv = *(const v4u*)(zr + ZV + c0), zu = *(const v4u*)(zr + ZU + c0);
    const f32x4 lg0 = *(const f32x4*)(lng + c0), lg1 = *(const f32x4*)(lng + c0 + 4), lb0 = *(const f32x4*)(lnb + c0), lb1 = *(const f32x4*)(lnb + c0 + 4);
    float x[8] = {gelu_f(bflo(zv.x)), gelu_f(bfhi(zv.x)), gelu_f(bflo(zv.y)), gelu_f(bfhi(zv.y)), gelu_f(bflo(zv.z)), gelu_f(bfhi(zv.z)), gelu_f(bflo(zv.w)), gelu_f(bfhi(zv.w))};
    float s1 = 0.f, s2 = 0.f;
#pragma unroll
    for (int e = 0; e < 8; ++e) { s1 += x[e]; s2 += x[e] * x[e]; }
    s1 = wave_sum(s1); s2 = wave_sum(s2);
    const float mean = s1 * (1.f / 512.f), var = fmaxf(s2 * (1.f / 512.f) - mean * mean, 0.f), rstd = rsqrtf(var + EPS);
    f32x4 v0, v1;
#pragma unroll
    for (int e = 0; e < 4; ++e) { v0[e] = (x[e] - mean) * rstd * lg0[e] + lb0[e]; v1[e] = (x[4 + e] - mean) * rstd * lg1[e] + lb1[e]; }
    float* vo = a.out + O_VS + ((size_t)(b * DSEQ + t)) * 512 + c0; *(f32x4*)vo = v0; *(f32x4*)(vo + 4) = v1;
    *(LAS f32x4*)(VS + t * 512 + c0) = v0; *(LAS f32x4*)(VS + t * 512 + c0 + 4) = v1;
    __syncthreads();
    const float bs = bsp[g * 128 + t];
    f32x4 m0v = (f32x4){bs, bs, bs, bs}, m1v = m0v;
    const float* wrow = wsp + (size_t)g * 16384 + t * 128;
    for (int s = 0; s <= t; ++s) { const float w = wrow[s]; m0v += w * *(const LAS f32x4*)(VS + s * 512 + c0); m1v += w * *(const LAS f32x4*)(VS + s * 512 + c0 + 4); }
    v4u o;
    o.x = pg8::cvt_pk_bf16(gelu_f(bflo(zu.x)) * m0v[0], gelu_f(bfhi(zu.x)) * m0v[1]); o.y = pg8::cvt_pk_bf16(gelu_f(bflo(zu.y)) * m0v[2], gelu_f(bfhi(zu.y)) * m0v[3]);
    o.z = pg8::cvt_pk_bf16(gelu_f(bflo(zu.z)) * m1v[0], gelu_f(bfhi(zu.z)) * m1v[1]); o.w = pg8::cvt_pk_bf16(gelu_f(bflo(zu.w)) * m1v[2], gelu_f(bfhi(zu.w)) * m1v[3]);
    *(v4u*)(H + (size_t)(m0 + t) * DM + 512 + c0) = o;
    __syncthreads();
}
__device__ __forceinline__ void phase_m1(const Args& a, const Ctx& C) {
    constexpr int N_A = NBP * 4 * 32, N_S = NBS * 4, N_C = NBP * 16 * 4, N_D = NBS;
    for (int it = C.vcu; it < N_A + N_S + N_C + N_D; it += C.G) {
        if (it < N_A) hgrn_pass_a(a, C, it);
        else if (it < N_A + N_S) hgrn_sample(a, C, it - N_A);
        else if (it < N_A + N_S + N_C) cmlp_prompt(a, C, it - N_A - N_S);
        else cmlp_sample(a, C, it - N_A - N_S - N_C);
    }
}
__device__ __forceinline__ void phase_m2(const Args& a, const Ctx& C) {
    float* DS = (float*)(a.ws + WS_DS); const float* DEC = (const float*)(a.ws + WS_DEC);
    for (int e = C.vcu * NTHR + C.tid; e < 32 * 4096; e += C.G * NTHR) {
        const int bh = e >> 12, idx = e & 4095, v = idx >> 5, k4 = (idx & 31) * 4;
        f32x4 S = (f32x4){0.f, 0.f, 0.f, 0.f};
        float* p = DS + (size_t)bh * 32 * 16384 + v * 128 + k4; const float* dp = DEC + (size_t)bh * 32 * 128 + k4;
#pragma unroll 8
        for (int n = 0; n < 32; ++n) { const f32x4 ds = *(const f32x4*)(p + (size_t)n * 16384), dc = *(const f32x4*)(dp + n * 128);
            *(f32x4*)(p + (size_t)n * 16384) = S; S = dc * S + ds; }
        float* so = a.out + O_SP + (size_t)bh * 16384 + v;
#pragma unroll
        for (int c = 0; c < 4; ++c) so[(size_t)(k4 + c) * 128] = S[c];
    }
}
__device__ __forceinline__ void hgrn_pass_c(const Args& a, const Ctx& C, int item, int par) {
    const bf16* Z = (const bf16*)(a.ws + WS_Z); bf16* H = (bf16*)(a.ws + WS_H); const float* DS = (const float*)(a.ws + WS_DS);
    const bf16* QDG = (const bf16*)((unsigned char*)a.out + OUT_QD); const float* OI = (const float*)((unsigned char*)a.out + OUT_OI); const float* gnw = a.in[11];
    const int bh = item >> 5, n = item & 31, b = bh >> 2, h = bh & 3, tok0 = b * SEQ + n * 64;
    const int w = C.wave, i = C.lane & 15, kq = C.lane >> 4, v0 = 16 * w + kq * 4;
    const float* sp = DS + (size_t)item * 16384 + (size_t)(16 * w + i) * 128 + kq * 8;
    f32x4 sa[4][2];
#pragma unroll
    for (int ks = 0; ks < 4; ++ks) { sa[ks][0] = *(const f32x4*)(sp + ks * 32); sa[ks][1] = *(const f32x4*)(sp + ks * 32 + 4); }
    bf16x8 Bq[4][4]; f32x4 oi[4]; v2u zgv[4];
#pragma unroll
    for (int tb = 0; tb < 4; ++tb) { const size_t tok = (size_t)(tok0 + 16 * tb + i);
#pragma unroll
        for (int ks = 0; ks < 4; ++ks) Bq[tb][ks] = *(const bf16x8*)(QDG + tok * 512 + h * 128 + ks * 32 + kq * 8);
        oi[tb] = *(const f32x4*)(OI + tok * 512 + h * 128 + v0); zgv[tb] = *(const v2u*)(Z + tok * NIN + ZG + h * 128 + v0); }
    const f32x4 gw = *(const f32x4*)(gnw + v0);
    bf16x8 Af[4];
#pragma unroll
    for (int ks = 0; ks < 4; ++ks) Af[ks] = pack8(sa[ks][0], sa[ks][1]);
    f32x4 o[4]; float ss[4];
#pragma unroll
    for (int tb = 0; tb < 4; ++tb) { f32x4 acc = oi[tb];
#pragma unroll
        for (int ks = 0; ks < 4; ++ks) acc = MFMA16(Af[ks], Bq[tb][ks], acc);
        o[tb] = acc; float q = SQ4(acc); q += __shfl_xor(q, 16); q += __shfl_xor(q, 32); ss[tb] = q; }
    LAS float* SS = (LAS float*)C.lds + par * 512;
    if (kq == 0) {
#pragma unroll
        for (int tb = 0; tb < 4; ++tb) SS[w * 64 + 16 * tb + i] = ss[tb]; }
    __syncthreads();
#pragma unroll
    for (int tb = 0; tb < 4; ++tb) { float tot = 0.f;
#pragma unroll
        for (int ww = 0; ww < 8; ++ww) tot += SS[ww * 64 + 16 * tb + i];
        const float rs = rsqrtf(tot * (1.f / 128.f) + EPS);
        const f32x4 zg = (f32x4){bflo(zgv[tb].x), bfhi(zgv[tb].x), bflo(zgv[tb].y), bfhi(zgv[tb].y)};
        store4bf(H + (size_t)(tok0 + 16 * tb + i) * DM + h * 128 + v0, (f32x4){o[tb][0] * rs * gw[0] * silu2_f(zg[0]), o[tb][1] * rs * gw[1] * silu2_f(zg[1]), o[tb][2] * rs * gw[2] * silu2_f(zg[2]), o[tb][3] * rs * gw[3] * silu2_f(zg[3])}); }
}
__device__ __forceinline__ void phase_m3(const Args& a, const Ctx& C) {
    int par = 0;
    for (int it = C.vcu; it < NBP * 4 * 32; it += C.G) { hgrn_pass_c(a, C, it, par); par ^= 1; }
    __syncthreads();
}

__global__ void __launch_bounds__(NTHR, 2) mk_fwd(Args args) {
    extern __shared__ __attribute__((aligned(16))) unsigned char lds_raw[];
    Ctx C;
    C.lds = (LAS unsigned char*)lds_raw;
    C.tid = threadIdx.x; C.lane = C.tid & 63; C.wave = __builtin_amdgcn_readfirstlane(C.tid >> 6);
    C.G = gridDim.x; { const int bx = blockIdx.x; C.vcu = (C.G % 8 == 0) ? (bx % 8) * (C.G / 8) + bx / 8 : bx; }
    volatile LAS unsigned* MISC = (volatile LAS unsigned*)(C.lds + MISC_OFF);
    for (int u = C.tid; u < (LDS_BYTES - LDSCTL_OFF) / 4; u += NTHR) ((LAS unsigned*)(C.lds + LDSCTL_OFF))[u] = 0u;
    __syncthreads();
    unsigned* barw = (unsigned*)(args.ws + WS_CTL) + CW_BAR;
    const int lo = args.ph_lo, hi = args.ph_hi;
    const bool multi = (hi - lo) > 1;
    XcdBarrier bar; bar.bar = barw; bar.x = 0; bar.st = nullptr;
    if (multi) bar = xcd_barrier_post(barw, MISC + 8);
    if (args.use_cg) cg::this_grid().sync();
#define IN(k) (lo <= (k) && (k) < hi)
#define SEAM(k) do { if (IN(k) && IN((k) + 1)) xcd_barrier(bar); } while (0)
    bf16* H = (bf16*)(args.ws + WS_H); bf16* Zb = (bf16*)(args.ws + WS_Z);
    if (IN(0)) { phase_p0(args, C); SEAM(0); }
    if (IN(1)) { phase_mod(args, C); SEAM(1); }
    if (IN(2)) { phase_p1(args, C); SEAM(2); }
    if (IN(3)) { pg8::Gemm g{H, (const bf16*)(args.ws + WS_WIN), MT, NIN, DM}; pg8::StaticOrder S; S.init(MT, NIN, DM, C.G, (int)blockIdx.x);
        pg8::EpiStore E{Zb, NIN, nullptr, 0, 0};
        pg8::gemm_phase<pg8::EpiStore, pg8::StaticOrder, true, true>(C.lds, g, S, E); SEAM(3); }
    if (IN(4)) { phase_m1(args, C); SEAM(4); }
    if (IN(5)) { phase_m2(args, C); SEAM(5); }
    if (IN(6)) { phase_m3(args, C); SEAM(6); }
    if (IN(7)) { pg8::Gemm g{H, (const bf16*)(args.ws + WS_WOUT), MT, DM, DM}; pg8::SplitOrder S; S.init(MP, MS, DM, DM, 4, C.G, (int)blockIdx.x);
        pg8::EpiStore E{(bf16*)(args.ws + WS_MB), DM, (float*)(args.ws + WS_PART), MP, MS};
        pg8::gemm_phase<pg8::EpiStore, pg8::SplitOrder, true, true>(C.lds, g, S, E); SEAM(7); }
    if (IN(8)) { phase_p5(args, C); SEAM(8); }
    if (IN(9)) { pg8::Gemm g{H, (const bf16*)(args.ws + WS_WGU), MT, NGU, DM}; pg8::StaticOrder S; S.init(MT, NGU, DM, C.G, (int)blockIdx.x);
        pg8::EpiSwiGLU E{(bf16*)(args.ws + WS_ACT), DFF};
        pg8::gemm_phase<pg8::EpiSwiGLU, pg8::StaticOrder, true, true>(C.lds, g, S, E); SEAM(9); }
    if (IN(10)) { pg8::Gemm g{(const bf16*)(args.ws + WS_ACT), (const bf16*)(args.ws + WS_WDN), MT, DM, DFF}; pg8::SplitOrder S; S.init(MP, MS, DM, DFF, 4, C.G, (int)blockIdx.x);
        pg8::EpiStore E{(bf16*)(args.ws + WS_FB), DM, (float*)(args.ws + WS_PART), MP, MS};
        pg8::gemm_phase<pg8::EpiStore, pg8::SplitOrder, true, true>(C.lds, g, S, E); SEAM(10); }
    if (IN(11)) { phase_p8(args, C); }
#undef IN
#undef SEAM
}

extern "C" void kernel_launch(void* const* d_in, const int* in_sizes, int n_in, void* d_out, int out_size, void* d_ws, size_t ws_size, hipStream_t stream) {
    static int grid = 0;
    if (grid == 0) {
        if (n_in != 22 || ws_size < 256 * MiB) { fprintf(stderr, "kernel_launch: unexpected inputs (n_in %d, ws %zu)\n", n_in, ws_size); grid = -1; return; }
        int dev = 0, cus = 0, per_cu = 0;
        if (hipGetDevice(&dev) != hipSuccess || hipDeviceGetAttribute(&cus, hipDeviceAttributeMultiprocessorCount, dev) != hipSuccess) { grid = -1; return; }
        if (hipFuncSetAttribute((const void*)mk_fwd, hipFuncAttributeMaxDynamicSharedMemorySize, LDS_BYTES) != hipSuccess) { fprintf(stderr, "kernel_launch: hipFuncSetAttribute failed\n"); grid = -1; return; }
        if (hipOccupancyMaxActiveBlocksPerMultiprocessor(&per_cu, (const void*)mk_fwd, NTHR, LDS_BYTES) != hipSuccess || per_cu < 1) { fprintf(stderr, "kernel_launch: occupancy query says %d\n", per_cu); per_cu = 1; }
        (void)hipGetLastError();
        grid = cus;
    }
    if (grid < 0) return;
    (void)hipMemsetAsync((char*)d_ws + WS_CTL, 0, CTL_ZERO_BYTES, stream);
    Args a{};
    for (int i = 0; i < 22; ++i) a.in[i] = (const float*)d_in[i];
    a.out = (float*)d_out; a.ws = (unsigned char*)d_ws; a.use_cg = 0; a.pad = 0;
#if MK_N_LAUNCHES == 1
    a.ph_lo = 0; a.ph_hi = NPH;
    void* kargs[] = {&a};
    hipError_t e = hipLaunchCooperativeKernel((const void*)mk_fwd, dim3(grid), dim3(NTHR), kargs, LDS_BYTES, stream);
    if (e != hipSuccess) fprintf(stderr, "kernel_launch: cooperative launch failed: %s (grid %d)\n", hipGetErrorString(e), grid);
#else
    for (int p = 0; p < NPH; ++p) { a.ph_lo = p; a.ph_hi = p + 1; hipLaunchKernelGGL(mk_fwd, dim3(grid), dim3(NTHR), LDS_BYTES, stream, a); }
#endif
}
```
